# Optimizing an MI355X kernel written in HIP

```python
import jax
import jax.numpy as jnp
from jax import lax
import numpy as np

D_MODEL = 1024
BATCH = 8
SEQ = 2048
DEPTH = 2

HEAD_DIM = 64
N_HEADS = 8
N_KV = 2
HPG = N_HEADS // N_KV
ATTN_W = N_HEADS * HEAD_DIM
KV_W = N_KV * HEAD_DIM
CONV_CH = D_MODEL - ATTN_W
CONV_W = 3
D_MIX = ATTN_W + CONV_CH
CMP_BLOCK = 32
CMP_STRIDE = 16
CMP_HIDDEN = 256
SEL_BLOCK = 64
SEL_TOPN = 16
WINDOW = 512
WIN_QBLOCK = 128
SEL_QCHUNK = 64
D_FF = 2816
N_EXPERTS = 8
TOP_K = 2
D_FF_EXPERT = 1408
N_DENSE = (DEPTH + 1) // 2
N_MOE = DEPTH // 2
ALPHA = (2 * DEPTH) ** 0.25
BETA = (8 * DEPTH) ** -0.25
LN_EPS = 1e-5
NEG = -1e30
FORCE = 1e9
SPLIT_WIDTHS = (ATTN_W, KV_W, KV_W, KV_W, KV_W, KV_W, KV_W, 3 * N_HEADS, CONV_CH, CONV_CH, CONV_CH)
D_IN = sum(SPLIT_WIDTHS)

kernel_name = 'hymba_nsa_shortconv_deepnorm_moe'


def layer_norm(x, g, b):
    xf = x.astype(jnp.float32)
    mu = jnp.mean(xf, -1, keepdims=True)
    var = jnp.mean(jnp.square(xf - mu), -1, keepdims=True)
    return ((xf - mu) * lax.rsqrt(var + LN_EPS) * g + b).astype(x.dtype)


def compress(k, pos, w1, b1, w2, b2):
    bsz, g, s, dh = k.shape
    ratio = CMP_BLOCK // CMP_STRIDE
    n_cmp = s // CMP_STRIDE - ratio + 1
    blocks = k.reshape(bsz, g, s // CMP_STRIDE, CMP_STRIDE, dh)
    win = jnp.concatenate([blocks[:, :, r:r + n_cmp] for r in range(ratio)], axis=3)
    win = (win + pos).reshape(bsz, g, n_cmp, CMP_BLOCK * dh)
    return jax.nn.gelu(win @ w1 + b1) @ w2 + b2


def cmp_attention(q, kc, vc):
    s_len = q.shape[3]
    n = kc.shape[2]
    t = jnp.arange(s_len)
    ends = jnp.arange(n) * CMP_STRIDE + CMP_BLOCK - 1
    mask = ends[None, :] <= t[:, None]
    sc = jnp.einsum('bghsd,bgnd->bghsn', q, kc).astype(jnp.float32) * HEAD_DIM ** -0.5
    p = jax.nn.softmax(jnp.where(mask, sc, NEG), axis=-1) * mask
    o = jnp.einsum('bghsn,bgnd->bghsd', p.astype(vc.dtype), vc)
    return o, p


def select_blocks(p_cmp, s_len):
    n = p_cmp.shape[-1]
    n_sel = s_len // SEL_BLOCK
    cs = jnp.arange(n) * CMP_STRIDE
    ss = jnp.arange(n_sel) * SEL_BLOCK
    overlap = ((cs[:, None] < ss[None, :] + SEL_BLOCK) & (cs[:, None] + CMP_BLOCK > ss[None, :])).astype(jnp.float32)
    imp = jnp.einsum('bghsn,nj->bgsj', p_cmp, overlap)
    t = jnp.arange(s_len)[:, None]
    j = jnp.arange(n_sel)[None, :]
    cur = t // SEL_BLOCK
    valid = j * SEL_BLOCK <= t
    forced = (j == 0) | (j == cur) | (j == cur - 1)
    score = jnp.where(forced, FORCE, jnp.where(valid, imp, NEG))
    _, idx = lax.top_k(score, min(SEL_TOPN, n_sel))
    return idx


def sel_attention(q, ks, vs, idx):
    bsz, g, hpg, s_len, dh = q.shape
    n_sel = s_len // SEL_BLOCK
    k_top = idx.shape[-1]
    nc = s_len // SEL_QCHUNK
    kb = ks.reshape(bsz, g, n_sel, SEL_BLOCK, dh)
    vb = vs.reshape(bsz, g, n_sel, SEL_BLOCK, dh)
    qc = q.reshape(bsz, g, hpg, nc, SEL_QCHUNK, dh).transpose(3, 0, 1, 2, 4, 5)
    ic = idx.reshape(bsz, g, nc, SEL_QCHUNK, k_top).transpose(2, 0, 1, 3, 4)
    starts = jnp.arange(nc) * SEL_QCHUNK
    gather = jax.vmap(jax.vmap(lambda blk, ix: blk[ix]))

    def chunk(args):
        qq, ii, start = args
        kg = gather(kb, ii)
        vg = gather(vb, ii)
        sc = jnp.einsum('bghqd,bgqkrd->bghqkr', qq, kg).astype(jnp.float32) * HEAD_DIM ** -0.5
        pos = ii[..., None] * SEL_BLOCK + jnp.arange(SEL_BLOCK)
        tq = start + jnp.arange(SEL_QCHUNK)
        mask = (pos <= tq[None, None, :, None, None])[:, :, None]
        sc = jnp.where(mask, sc, NEG).reshape(bsz, g, hpg, SEL_QCHUNK, k_top * SEL_BLOCK)
        p = jax.nn.softmax(sc, axis=-1).reshape(bsz, g, hpg, SEL_QCHUNK, k_top, SEL_BLOCK)
        return jnp.einsum('bghqkr,bgqkrd->bghqd', p.astype(vg.dtype), vg)

    o = lax.map(chunk, (qc, ic, starts))
    return o.transpose(1, 2, 3, 0, 4, 5).reshape(bsz, g, hpg, s_len, dh)


def win_attention(q, kw, vw):
    bsz, g, hpg, s_len, dh = q.shape
    nb = s_len // WIN_QBLOCK
    span = WINDOW // WIN_QBLOCK
    ksz = (span + 1) * WIN_QBLOCK
    padw = ((0, 0), (0, 0), (WINDOW, 0), (0, 0))
    kp = jnp.pad(kw, padw).reshape(bsz, g, nb + span, WIN_QBLOCK, dh)
    vp = jnp.pad(vw, padw).reshape(bsz, g, nb + span, WIN_QBLOCK, dh)
    kband = jnp.concatenate([kp[:, :, i:i + nb] for i in range(span + 1)], axis=3)
    vband = jnp.concatenate([vp[:, :, i:i + nb] for i in range(span + 1)], axis=3)
    qb = q.reshape(bsz, g, hpg, nb, WIN_QBLOCK, dh)
    sc = jnp.einsum('bghnqd,bgnkd->bghnqk', qb, kband).astype(jnp.float32) * HEAD_DIM ** -0.5
    blk = jnp.arange(nb)[:, None, None] * WIN_QBLOCK
    tq = blk + jnp.arange(WIN_QBLOCK)[None, :, None]
    sk = blk - WINDOW + jnp.arange(ksz)[None, None, :]
    mask = (sk <= tq) & (tq - sk < WINDOW) & (sk >= 0)
    p = jax.nn.softmax(jnp.where(mask, sc, NEG), axis=-1)
    o = jnp.einsum('bghnqk,bgnkd->bghnqd', p.astype(vband.dtype), vband)
    return o.reshape(bsz, g, hpg, s_len, dh)


def short_conv(u, b_gate, c_gate, w):
    s_len = u.shape[1]
    z = jnp.pad(c_gate * u, ((0, 0), (CONV_W - 1, 0), (0, 0)))
    y = z[:, 0:s_len] * w[0]
    for i in range(1, CONV_W):
        y = y + z[:, i:i + s_len] * w[i]
    return b_gate * y


def hybrid_mixer(h, w_in, cmp_pos, cmp_w1, cmp_b1, cmp_w2, cmp_b2, conv_w, w_o):
    bsz, s_len, _ = h.shape
    z = h @ w_in
    offsets = np.cumsum(SPLIT_WIDTHS)[:-1].tolist()
    q, kc, vc, ks, vs, kw, vw, gates, u, bg, cg = jnp.split(z, offsets, axis=-1)
    q = q.reshape(bsz, s_len, N_KV, HPG, HEAD_DIM).transpose(0, 2, 3, 1, 4)

    def kv(t):
        return t.reshape(bsz, s_len, N_KV, HEAD_DIM).transpose(0, 2, 1, 3)

    kc_c = compress(kv(kc), cmp_pos[0], cmp_w1[0], cmp_b1[0], cmp_w2[0], cmp_b2[0])
    vc_c = compress(kv(vc), cmp_pos[1], cmp_w1[1], cmp_b1[1], cmp_w2[1], cmp_b2[1])
    o_cmp, p_cmp = cmp_attention(q, kc_c, vc_c)
    idx = select_blocks(p_cmp, s_len)
    o_sel = sel_attention(q, kv(ks), kv(vs), idx)
    o_win = win_attention(q, kv(kw), kv(vw))
    g = jax.nn.sigmoid(gates).reshape(bsz, s_len, 3, N_KV, HPG).transpose(2, 0, 3, 4, 1)[..., None]
    o_attn = g[0] * o_cmp + g[1] * o_sel + g[2] * o_win
    o_attn = o_attn.transpose(0, 3, 1, 2, 4).reshape(bsz, s_len, ATTN_W)
    o_conv = short_conv(u, bg, cg, conv_w)
    return jnp.concatenate([o_attn, o_conv], axis=-1) @ w_o


def swiglu(h, wg, wu, wd):
    return (jax.nn.silu(h @ wg) * (h @ wu)) @ wd


def moe_swiglu(h, w_router, wg, wu, wd):
    logits = (h @ w_router).astype(jnp.float32)
    top_v, top_i = lax.top_k(logits, TOP_K)
    w_top = jax.nn.softmax(top_v, axis=-1)
    gate = jnp.sum(jax.nn.one_hot(top_i, N_EXPERTS, dtype=jnp.float32) * w_top[..., None], axis=-2)
    out = jnp.zeros_like(h)
    for e in range(N_EXPERTS):
        out = out + gate[..., e:e + 1].astype(h.dtype) * swiglu(h, wg[e], wu[e], wd[e])
    return out


def setup_inputs(seed: int = 0) -> dict:
    key = jax.random.key(seed)
    ks = jax.random.split(key, 24)

    def nrm(k, shape, scale):
        return jax.random.normal(k, shape, jnp.float32) * scale

    return {
        'x': nrm(ks[0], (BATCH, SEQ, D_MODEL), 1.0),
        'ln_in_g': 1.0 + nrm(ks[1], (D_MODEL,), 0.02),
        'ln_in_b': nrm(ks[2], (D_MODEL,), 0.02),
        'w_in': nrm(ks[3], (DEPTH, D_MODEL, D_IN), D_MODEL ** -0.5),
        'cmp_pos': nrm(ks[4], (DEPTH, 2, CMP_BLOCK, HEAD_DIM), 0.1),
        'cmp_w1': nrm(ks[5], (DEPTH, 2, CMP_BLOCK * HEAD_DIM, CMP_HIDDEN), (CMP_BLOCK * HEAD_DIM) ** -0.5),
        'cmp_b1': nrm(ks[6], (DEPTH, 2, CMP_HIDDEN), 0.02),
        'cmp_w2': nrm(ks[7], (DEPTH, 2, CMP_HIDDEN, HEAD_DIM), CMP_HIDDEN ** -0.5),
        'cmp_b2': nrm(ks[8], (DEPTH, 2, HEAD_DIM), 0.02),
        'conv_w': nrm(ks[9], (DEPTH, CONV_W, CONV_CH), CONV_W ** -0.5),
        'w_o': nrm(ks[10], (DEPTH, D_MIX, D_MODEL), BETA * D_MIX ** -0.5),
        'ln1_g': 1.0 + nrm(ks[11], (DEPTH, D_MODEL), 0.02),
        'ln1_b': nrm(ks[12], (DEPTH, D_MODEL), 0.02),
        'ln2_g': 1.0 + nrm(ks[13], (DEPTH, D_MODEL), 0.02),
        'ln2_b': nrm(ks[14], (DEPTH, D_MODEL), 0.02),
        'ffn_wg': nrm(ks[15], (N_DENSE, D_MODEL, D_FF), D_MODEL ** -0.5),
        'ffn_wu': nrm(ks[16], (N_DENSE, D_MODEL, D_FF), D_MODEL ** -0.5),
        'ffn_wd': nrm(ks[17], (N_DENSE, D_FF, D_MODEL), BETA * D_FF ** -0.5),
        'moe_router': nrm(ks[18], (N_MOE, D_MODEL, N_EXPERTS), D_MODEL ** -0.5),
        'moe_wg': nrm(ks[19], (N_MOE, N_EXPERTS, D_MODEL, D_FF_EXPERT), D_MODEL ** -0.5),
        'moe_wu': nrm(ks[20], (N_MOE, N_EXPERTS, D_MODEL, D_FF_EXPERT), D_MODEL ** -0.5),
        'moe_wd': nrm(ks[21], (N_MOE, N_EXPERTS, D_FF_EXPERT, D_MODEL), BETA * D_FF_EXPERT ** -0.5),
    }


def reference(x, ln_in_g, ln_in_b, w_in, cmp_pos, cmp_w1, cmp_b1, cmp_w2, cmp_b2, conv_w, w_o,
              ln1_g, ln1_b, ln2_g, ln2_b, ffn_wg, ffn_wu, ffn_wd,
              moe_router, moe_wg, moe_wu, moe_wd):
    h = layer_norm(x, ln_in_g, ln_in_b)
    for l in range(DEPTH):
        m = hybrid_mixer(h, w_in[l], cmp_pos[l], cmp_w1[l], cmp_b1[l], cmp_w2[l], cmp_b2[l],
                         conv_w[l], w_o[l])
        h = layer_norm(ALPHA * h + m, ln1_g[l], ln1_b[l])
        if l % 2 == 0:
            f = swiglu(h, ffn_wg[l // 2], ffn_wu[l // 2], ffn_wd[l // 2])
        else:
            f = moe_swiglu(h, moe_router[l // 2], moe_wg[l // 2], moe_wu[l // 2], moe_wd[l // 2])
        h = layer_norm(ALPHA * h + f, ln2_g[l], ln2_b[l])
    return h
```

```cpp
#include <hip/hip_runtime.h>
#include <stdint.h>
#include <math.h>

typedef unsigned short bf16_t;

constexpr int DM = 1024, BATCH = 8, SEQ = 2048, DEPTH = 2;
constexpr int MTOK = BATCH * SEQ;
constexpr int NH = 8, NG = 2, HPG = 4, HD = 64;
constexpr int DIN = 2840, DINP = 3072;
constexpr int NCMP = 127, CMPH = 256;
constexpr int DFF = 2816, NEXP = 8, DFFE = 1408;
constexpr int ZQP = 1280;
constexpr int ZCP = 1536;
constexpr int GP = 32;
constexpr float ALPHA = 1.41421356237309515f;
constexpr float LN_EPS = 1e-5f;

constexpr size_t OFF_CTL = 0;
constexpr size_t SZ_WIN_T = (size_t)DINP * DM * 2;
constexpr size_t OFF_WIN_T = 1u << 20;
constexpr size_t OFF_CW1_T = OFF_WIN_T + 2 * SZ_WIN_T;
constexpr size_t OFF_WO_T = OFF_CW1_T + 4 * 1048576;
constexpr size_t OFF_FGU_T = OFF_WO_T + 2 * 2097152;
constexpr size_t OFF_FD_T = OFF_FGU_T + (size_t)2 * DFF * DM * 2;
constexpr size_t OFF_MGU_T = OFF_FD_T + (size_t)DM * DFF * 2;
constexpr size_t OFF_MD_T = OFF_MGU_T + (size_t)NEXP * 2 * DFFE * DM * 2;
constexpr size_t OFF_HB = OFF_MD_T + (size_t)NEXP * DM * DFFE * 2;
constexpr size_t OFF_OATT = OFF_HB + (size_t)MTOK * DM * 2;
constexpr size_t OFF_ZQ = OFF_OATT + (size_t)MTOK * DM * 2;
constexpr size_t OFF_ZC = OFF_ZQ + (size_t)MTOK * ZQP * 2;
constexpr size_t OFF_GATES = OFF_ZC + (size_t)MTOK * ZCP * 2;
constexpr size_t OFF_KC = OFF_GATES + (size_t)MTOK * GP * 4;
constexpr size_t OFF_SELM = OFF_KC + 1048576;
constexpr size_t OFF_TOPE = OFF_SELM + 131072;
constexpr size_t OFF_TOPW = OFF_TOPE + 131072;
constexpr size_t OFF_LIST = OFF_TOPW + 131072;
constexpr size_t WS_END = OFF_LIST + 524288;
static_assert(WS_END <= 280552448ull, "d_ws map exceeds the guaranteed workspace");
static_assert((size_t)MTOK * DFF * 2 == (size_t)MTOK * (ZQP + ZCP) * 2, "ACT overlays ZQ+ZC exactly");
constexpr int CW_CNT = 64;

__device__ __forceinline__ float bf2f(bf16_t v) { return __uint_as_float((unsigned)v << 16); }
__device__ __forceinline__ bf16_t f2bf(float f) { unsigned u = __float_as_uint(f); return (bf16_t)((u + 0x7fffu + ((u >> 16) & 1u)) >> 16); }
__device__ __forceinline__ float wave_sum(float v) {
#pragma unroll
    for (int o = 32; o > 0; o >>= 1) v += __shfl_xor(v, o);
    return v;
}
__device__ __forceinline__ float wave_max(float v) {
#pragma unroll
    for (int o = 32; o > 0; o >>= 1) v = fmaxf(v, __shfl_xor(v, o));
    return v;
}

__device__ __forceinline__ int map_row(int n, int mode) {
    if (mode == 1) return n < 1280 ? n : (n < 1304 ? 2816 + (n - 1280) : 1280 + (n - 1304));
    if (mode == 2) return (n >> 7) * 256 + (n & 127);
    if (mode == 3) return (n >> 7) * 256 + 128 + (n & 127);
    return n;
}
__global__ void __launch_bounds__(256) k_transpose_w(const float* __restrict__ W, int K, int N, bf16_t* __restrict__ WT, int mode, int ntn) {
    __shared__ float scr[64][33];
    const int tid = threadIdx.x;
    for (int item = blockIdx.x; item < (K / 64) * ntn; item += gridDim.x) {
        const int kb = item / ntn, nb = item % ntn, k0 = kb * 64, n0 = nb * 32;
        __syncthreads();
        for (int i = tid; i < 64 * 32; i += 256) { const int kk = i >> 5, nn = i & 31, n = n0 + nn; scr[kk][nn] = n < N ? W[(size_t)(k0 + kk) * N + n] : 0.f; }
        __syncthreads();
        const int nn = tid >> 3, c = tid & 7, n = n0 + nn;
        if (n < N) {
            uint4 o;
            o.x = (unsigned)f2bf(scr[8 * c + 0][nn]) | ((unsigned)f2bf(scr[8 * c + 1][nn]) << 16);
            o.y = (unsigned)f2bf(scr[8 * c + 2][nn]) | ((unsigned)f2bf(scr[8 * c + 3][nn]) << 16);
            o.z = (unsigned)f2bf(scr[8 * c + 4][nn]) | ((unsigned)f2bf(scr[8 * c + 5][nn]) << 16);
            o.w = (unsigned)f2bf(scr[8 * c + 6][nn]) | ((unsigned)f2bf(scr[8 * c + 7][nn]) << 16);
            *(uint4*)(WT + (size_t)map_row(n, mode) * K + k0 + 8 * c) = o;
        }
    }
}
__global__ void k_zero16(uint4* p, size_t n16) {
    for (size_t i = (size_t)blockIdx.x * blockDim.x + threadIdx.x; i < n16; i += (size_t)gridDim.x * blockDim.x) p[i] = make_uint4(0, 0, 0, 0);
}

struct LnArgs { const float* X; const float* TMP; const bf16_t* TMPB; const bf16_t* PO; const int* tope; const float* topw; const unsigned* cnt; const float* g; const float* b; float* HF; bf16_t* HB; };
template <int MODE> __global__ void __launch_bounds__(256) k_ln(LnArgs a) {
    const int lane = threadIdx.x & 63, w = (blockIdx.x * 256 + threadIdx.x) >> 6, nw = (gridDim.x * 256) >> 6;
    for (int m = w; m < MTOK; m += nw) {
        float4 v[4];
        if (MODE == 0) {
#pragma unroll
            for (int j = 0; j < 4; ++j) v[j] = ((const float4*)(a.X + (size_t)m * DM))[64 * j + lane];
        } else {
#pragma unroll
            for (int j = 0; j < 4; ++j) { float4 h = ((const float4*)(a.HF + (size_t)m * DM))[64 * j + lane]; v[j] = make_float4(ALPHA * h.x, ALPHA * h.y, ALPHA * h.z, ALPHA * h.w); }
            if (MODE == 1) {
#pragma unroll
                for (int j = 0; j < 4; ++j) { float4 t = ((const float4*)(a.TMP + (size_t)m * DM))[64 * j + lane]; v[j].x += t.x; v[j].y += t.y; v[j].z += t.z; v[j].w += t.w; }
            } else if (MODE == 3) {
                const bf16_t* row = a.TMPB + (size_t)m * DM;
#pragma unroll
                for (int j = 0; j < 4; ++j) { const uint2 t = ((const uint2*)row)[64 * j + lane];
                    v[j].x += bf2f((bf16_t)(t.x & 0xffff)); v[j].y += bf2f((bf16_t)(t.x >> 16)); v[j].z += bf2f((bf16_t)(t.y & 0xffff)); v[j].w += bf2f((bf16_t)(t.y >> 16)); }
            } else {
                int pre[NEXP]; int acc = 0;
#pragma unroll
                for (int e = 0; e < NEXP; ++e) { pre[e] = acc; acc += (int)a.cnt[e]; }
#pragma unroll
                for (int k = 0; k < 2; ++k) {
                    const int ep = a.tope[m * 2 + k], e = ep & 255, pos = ep >> 8; const float wk = a.topw[m * 2 + k];
                    int p = pos;
#pragma unroll
                    for (int e2 = 0; e2 < NEXP; ++e2) if (e2 == e) p += pre[e2];
                    const bf16_t* row = a.PO + (size_t)p * DM;
#pragma unroll
                    for (int j = 0; j < 4; ++j) { const uint2 t = ((const uint2*)row)[64 * j + lane];
                        v[j].x += wk * bf2f((bf16_t)(t.x & 0xffff)); v[j].y += wk * bf2f((bf16_t)(t.x >> 16)); v[j].z += wk * bf2f((bf16_t)(t.y & 0xffff)); v[j].w += wk * bf2f((bf16_t)(t.y >> 16)); }
                }
            }
        }
        float s = 0.f;
#pragma unroll
        for (int j = 0; j < 4; ++j) s += (v[j].x + v[j].y) + (v[j].z + v[j].w);
        const float mean = wave_sum(s) * (1.f / DM);
        float q = 0.f;
#pragma unroll
        for (int j = 0; j < 4; ++j) { v[j].x -= mean; v[j].y -= mean; v[j].z -= mean; v[j].w -= mean; q += (v[j].x * v[j].x + v[j].y * v[j].y) + (v[j].z * v[j].z + v[j].w * v[j].w); }
        const float rstd = 1.0f / sqrtf(wave_sum(q) * (1.f / DM) + LN_EPS);
#pragma unroll
        for (int j = 0; j < 4; ++j) {
            const float4 g = ((const float4*)a.g)[64 * j + lane], b = ((const float4*)a.b)[64 * j + lane];
            float4 o = make_float4(v[j].x * rstd * g.x + b.x, v[j].y * rstd * g.y + b.y, v[j].z * rstd * g.z + b.z, v[j].w * rstd * g.w + b.w);
            ((float4*)(a.HF + (size_t)m * DM))[64 * j + lane] = o;
            if (MODE != 2) { uint2 pk; pk.x = (unsigned)f2bf(o.x) | ((unsigned)f2bf(o.y) << 16); pk.y = (unsigned)f2bf(o.z) | ((unsigned)f2bf(o.w) << 16);
                ((uint2*)(a.HB + (size_t)m * DM))[64 * j + lane] = pk; }
        }
    }
}

struct GArgs { const bf16_t* A; const bf16_t* B; int K; bf16_t* O0; bf16_t* O1; float* OF; const unsigned* cnt; const int* list; };
template <int MODE> __global__ void __launch_bounds__(256) k_gemm_naive(GArgs a) {
    constexpr bool DUAL = (MODE == 2 || MODE == 4);
    constexpr bool MOE = (MODE >= 4);
    __shared__ __attribute__((aligned(16))) float As[32][68];
    __shared__ __attribute__((aligned(16))) float Bs[32][68];
    __shared__ __attribute__((aligned(16))) float Bs2[DUAL ? 32 : 1][68];
    const int tid = threadIdx.x, tx = tid & 15, ty = tid >> 4;
    const int n0 = blockIdx.x * 64;
    int mt = blockIdx.y, e = 0, rows_valid = 64, prow0 = 0;
    const bf16_t* Bb = a.B;
    if (MOE) {
        e = mt >> 8; const int rt = mt & 255; const int ce = (int)a.cnt[e];
        if (rt * 64 >= ce) return;
        rows_valid = min(64, ce - rt * 64);
        int pre = 0; for (int e2 = 0; e2 < e; ++e2) pre += (int)a.cnt[e2];
        prow0 = pre + rt * 64;
        Bb += (size_t)e * (MODE == 4 ? (size_t)2 * DFFE * DM : (size_t)DM * DFFE);
        mt = rt;
    }
    const int K = a.K;
    const int lr = tid >> 2, lc = (tid & 3) * 8;
    const bf16_t* arow;
    if (MODE == 4) { const int tok = (lr < rows_valid) ? a.list[e * MTOK + mt * 64 + lr] : 0; arow = a.A + (size_t)tok * K; }
    else if (MODE == 5) { int p = prow0 + lr; if (p > 2 * MTOK - 1) p = 2 * MTOK - 1; arow = a.A + (size_t)p * K; }
    else arow = a.A + (size_t)(mt * 64 + lr) * K;
    const int nl = n0 + lr;
    const bf16_t* brow = DUAL ? Bb + (size_t)((nl >> 7) * 256 + (nl & 127)) * K : Bb + (size_t)nl * K;
    const bf16_t* brow2 = DUAL ? brow + (size_t)128 * K : brow;
    float acc[4][4], acc2[4][4];
#pragma unroll
    for (int i = 0; i < 4; ++i)
#pragma unroll
        for (int j = 0; j < 4; ++j) { acc[i][j] = 0.f; acc2[i][j] = 0.f; }
    for (int k0 = 0; k0 < K; k0 += 32) {
        const uint4 av = *(const uint4*)(arow + k0 + lc);
        const uint4 bv = *(const uint4*)(brow + k0 + lc);
        uint4 bv2 = bv; if (DUAL) bv2 = *(const uint4*)(brow2 + k0 + lc);
        __syncthreads();
        const unsigned aw[4] = {av.x, av.y, av.z, av.w}, bw[4] = {bv.x, bv.y, bv.z, bv.w}, bw2[4] = {bv2.x, bv2.y, bv2.z, bv2.w};
#pragma unroll
        for (int i = 0; i < 4; ++i) {
            As[lc + 2 * i][lr] = __uint_as_float(aw[i] << 16); As[lc + 2 * i + 1][lr] = __uint_as_float(aw[i] & 0xffff0000u);
            Bs[lc + 2 * i][lr] = __uint_as_float(bw[i] << 16); Bs[lc + 2 * i + 1][lr] = __uint_as_float(bw[i] & 0xffff0000u);
            if (DUAL) { Bs2[lc + 2 * i][lr] = __uint_as_float(bw2[i] << 16); Bs2[lc + 2 * i + 1][lr] = __uint_as_float(bw2[i] & 0xffff0000u); }
        }
        __syncthreads();
#pragma unroll 8
        for (int k = 0; k < 32; ++k) {
            const float4 a4 = *(const float4*)&As[k][ty * 4];
            const float4 b4 = *(const float4*)&Bs[k][tx * 4];
            const float af[4] = {a4.x, a4.y, a4.z, a4.w}, bf[4] = {b4.x, b4.y, b4.z, b4.w};
#pragma unroll
            for (int i = 0; i < 4; ++i)
#pragma unroll
                for (int j = 0; j < 4; ++j) acc[i][j] += af[i] * bf[j];
            if (DUAL) {
                const float4 c4 = *(const float4*)&Bs2[k][tx * 4];
                const float cf[4] = {c4.x, c4.y, c4.z, c4.w};
#pragma unroll
                for (int i = 0; i < 4; ++i)
#pragma unroll
                    for (int j = 0; j < 4; ++j) acc2[i][j] += af[i] * cf[j];
            }
        }
    }
#pragma unroll
    for (int i = 0; i < 4; ++i) {
        const int r = ty * 4 + i;
        if (MOE && r >= rows_valid) continue;
        const size_t m = MOE ? (size_t)(prow0 + r) : (size_t)(mt * 64 + r);
#pragma unroll
        for (int j = 0; j < 4; ++j) {
            const int n = n0 + tx * 4 + j; const float v = acc[i][j];
            if (MODE == 0) {
                if (n < 1280) a.O0[m * ZQP + n] = f2bf(v);
                else if (n < 2816) a.O1[m * ZCP + (n - 1280)] = f2bf(v);
                else if (n < 2840) a.OF[m * GP + (n - 2816)] = v;
            } else if (MODE == 1) a.OF[m * DM + n] = v;
            else if (MODE == 3) a.O0[m * DM + n] = f2bf(v);
            else if (MODE == 2) { const float u = acc2[i][j]; a.O0[m * DFF + n] = f2bf(v / (1.f + expf(-v)) * u); }
            else if (MODE == 4) { const float u = acc2[i][j]; a.O0[m * DFFE + n] = f2bf(v / (1.f + expf(-v)) * u); }
            else if (MODE == 5) a.O0[m * DM + n] = f2bf(v);
        }
    }
}

__global__ void __launch_bounds__(256) k_compress(const bf16_t* __restrict__ ZQ, const float* __restrict__ pos, const float* __restrict__ w1, const float* __restrict__ b1,
                                                  const float* __restrict__ w2, const float* __restrict__ b2, float* __restrict__ KC) {
    __shared__ float win[2048];
    __shared__ float hid[256];
    const int tid = threadIdx.x;
    for (int item = blockIdx.x; item < 2 * BATCH * NG * NCMP; item += gridDim.x) {
        const int i = item % NCMP, bg = (item / NCMP) % (BATCH * NG), kv = item / (NCMP * BATCH * NG);
        const int b = bg / NG, g = bg % NG;
        __syncthreads();
        for (int k = tid; k < 2048; k += 256) { const int r = k >> 6, d = k & 63;
            win[k] = bf2f(ZQ[(size_t)(b * SEQ + 16 * i + r) * ZQP + 512 + kv * 128 + g * 64 + d]) + pos[kv * 2048 + k]; }
        __syncthreads();
        float acc = b1[kv * CMPH + tid];
        const float* w = w1 + (size_t)kv * 2048 * CMPH + tid;
        for (int k = 0; k < 2048; ++k) acc += win[k] * w[(size_t)k * CMPH];
        const float x = acc;
        hid[tid] = 0.5f * x * (1.f + tanhf(0.7978845608028654f * (x + 0.044715f * x * x * x)));
        __syncthreads();
        if (tid < 64) { float o = b2[kv * HD + tid]; const float* ww = w2 + (size_t)kv * CMPH * HD + tid;
            for (int n = 0; n < CMPH; ++n) o += hid[n] * ww[n * HD];
            KC[((size_t)(kv * BATCH * NG + bg) * 128 + i) * HD + tid] = o; }
    }
}

__global__ void k_conv(const bf16_t* __restrict__ ZC, const float* __restrict__ cw, bf16_t* __restrict__ OATT) {
    for (size_t idx = (size_t)blockIdx.x * blockDim.x + threadIdx.x; idx < (size_t)MTOK * 512; idx += (size_t)gridDim.x * blockDim.x) {
        const int ch = (int)(idx & 511); const size_t m = idx >> 9; const int t = (int)(m % SEQ);
        float y = 0.f;
#pragma unroll
        for (int i = 0; i < 3; ++i) { const int dt = 2 - i; if (t - dt >= 0) { const bf16_t* r = ZC + (m - dt) * ZCP; y += bf2f(r[1024 + ch]) * bf2f(r[ch]) * cw[i * 512 + ch]; } }
        OATT[m * DM + 512 + ch] = f2bf(bf2f(ZC[m * ZCP + 512 + ch]) * y);
    }
}

__device__ __forceinline__ float dot64_bf(const float (&q)[64], const bf16_t* kr) {
    float s = 0.f;
#pragma unroll
    for (int c = 0; c < 8; ++c) { const uint4 v = ((const uint4*)kr)[c];
        s += q[8 * c + 0] * __uint_as_float(v.x << 16) + q[8 * c + 1] * __uint_as_float(v.x & 0xffff0000u) + q[8 * c + 2] * __uint_as_float(v.y << 16) + q[8 * c + 3] * __uint_as_float(v.y & 0xffff0000u)
           + q[8 * c + 4] * __uint_as_float(v.z << 16) + q[8 * c + 5] * __uint_as_float(v.z & 0xffff0000u) + q[8 * c + 6] * __uint_as_float(v.w << 16) + q[8 * c + 7] * __uint_as_float(v.w & 0xffff0000u); }
    return s;
}
__device__ __forceinline__ float dot64_f(const float (&q)[64], const float* kr) {
    float s = 0.f;
#pragma unroll
    for (int c = 0; c < 16; ++c) { const float4 v = ((const float4*)kr)[c]; s += q[4 * c] * v.x + q[4 * c + 1] * v.y + q[4 * c + 2] * v.z + q[4 * c + 3] * v.w; }
    return s;
}
__device__ __forceinline__ void online_block(float s, bool valid, const bf16_t* vcol, int vstride, float& m, float& l, float& o) {
    const float sv = valid ? s : -INFINITY;
    const float bm = wave_max(sv);
    if (bm == -INFINITY) return;
    const float mn = fmaxf(m, bm);
    const float sc = expf(m - mn);
    const float p = valid ? expf(s - mn) : 0.f;
    l = l * sc + wave_sum(p);
    o *= sc;
    for (int k = 0; k < 64; ++k) { const float pk = __shfl(p, k); o += pk * bf2f(vcol[(size_t)k * vstride]); }
    m = mn;
}
__global__ void __launch_bounds__(256) k_attn_naive(const bf16_t* __restrict__ ZQ, const float* __restrict__ GATES, const float* __restrict__ KC, const float* __restrict__ VC,
                                                    bf16_t* __restrict__ OATT, unsigned* __restrict__ SELM) {
    __shared__ float pl[4][128];
    const int lane = threadIdx.x & 63, j = threadIdx.x >> 6;
    for (int item = blockIdx.x; item < MTOK * NG; item += gridDim.x) {
        const int g = item % NG; const int m = item / NG; const int b = m / SEQ, t = m % SEQ; const int head = g * HPG + j;
        const bf16_t* zrow = ZQ + (size_t)m * ZQP;
        float q[64];
#pragma unroll
        for (int c = 0; c < 8; ++c) { const uint4 v = ((const uint4*)(zrow + head * HD))[c];
            q[8 * c + 0] = __uint_as_float(v.x << 16); q[8 * c + 1] = __uint_as_float(v.x & 0xffff0000u); q[8 * c + 2] = __uint_as_float(v.y << 16); q[8 * c + 3] = __uint_as_float(v.y & 0xffff0000u);
            q[8 * c + 4] = __uint_as_float(v.z << 16); q[8 * c + 5] = __uint_as_float(v.z & 0xffff0000u); q[8 * c + 6] = __uint_as_float(v.w << 16); q[8 * c + 7] = __uint_as_float(v.w & 0xffff0000u); }
        const bf16_t* zb = ZQ + (size_t)b * SEQ * ZQP;
        const float* kc = KC + (size_t)(b * NG + g) * 128 * HD; const float* vc = VC + (size_t)(b * NG + g) * 128 * HD;
        const int n0 = lane, n1 = lane + 64;
        const bool v0 = (16 * n0 + 31 <= t), v1 = (n1 < NCMP) && (16 * n1 + 31 <= t);
        const float s0 = dot64_f(q, kc + n0 * HD) * 0.125f, s1 = dot64_f(q, kc + (n1 < 128 ? n1 : 127) * HD) * 0.125f;
        const float mx = wave_max(fmaxf(v0 ? s0 : -INFINITY, v1 ? s1 : -INFINITY));
        float p0 = 0.f, p1 = 0.f;
        if (mx != -INFINITY) { p0 = v0 ? expf(s0 - mx) : 0.f; p1 = v1 ? expf(s1 - mx) : 0.f; const float inv = 1.f / wave_sum(p0 + p1); p0 *= inv; p1 *= inv; }
        __syncthreads();
        pl[j][n0] = p0; pl[j][n1] = p1;
        float ocmp = 0.f;
        for (int n = 0; n < 64; ++n) ocmp += __shfl(p0, n) * vc[n * HD + lane];
        for (int n = 0; n < 63; ++n) ocmp += __shfl(p1, n) * vc[(64 + n) * HD + lane];
        __syncthreads();
        unsigned mask;
        {
            const int jj = lane & 31; float imp = 0.f;
            for (int n = 4 * jj - 1; n <= 4 * jj + 3; ++n) if (n >= 0 && n < NCMP) imp += (pl[0][n] + pl[1][n]) + (pl[2][n] + pl[3][n]);
            const int cur = t >> 6; const bool valid = (64 * jj <= t), forced = (jj == 0) || (jj == cur) || (jj == cur - 1);
            const float score = forced ? 1e9f : (valid ? imp : -1e30f);
            int rank = 0;
            for (int jp = 0; jp < 32; ++jp) { const float sp = __shfl(score, jp, 32); rank += (sp > score || (sp == score && jp < jj)) ? 1 : 0; }
            mask = (unsigned)(__ballot(rank < 16) & 0xffffffffull);
        }
        if (j == 0 && lane == 0) SELM[m * NG + g] = mask;
        float osel;
        {
            float mm = -INFINITY, l = 0.f, o = 0.f; const int cur = t >> 6;
            for (int jb = 0; jb <= cur; ++jb) if ((mask >> jb) & 1u) {
                const int key = 64 * jb + lane;
                const float s = dot64_bf(q, zb + (size_t)key * ZQP + 768 + g * HD) * 0.125f;
                online_block(s, key <= t, zb + (size_t)(64 * jb) * ZQP + 896 + g * HD + lane, ZQP, mm, l, o);
            }
            osel = o / l;
        }
        float owin;
        {
            float mm = -INFINITY, l = 0.f, o = 0.f; const int lo = t - 511 > 0 ? t - 511 : 0;
            for (int kb = lo & ~63; kb <= t; kb += 64) {
                const int key = kb + lane;
                const float s = dot64_bf(q, zb + (size_t)key * ZQP + 1024 + g * HD) * 0.125f;
                online_block(s, key >= lo && key <= t, zb + (size_t)kb * ZQP + 1152 + g * HD + lane, ZQP, mm, l, o);
            }
            owin = o / l;
        }
        const float* gr = GATES + (size_t)m * GP;
        const float g0 = 1.f / (1.f + expf(-gr[head])), g1 = 1.f / (1.f + expf(-gr[8 + head])), g2 = 1.f / (1.f + expf(-gr[16 + head]));
        OATT[(size_t)m * DM + head * HD + lane] = f2bf(g0 * ocmp + g1 * osel + g2 * owin);
    }
}

__global__ void __launch_bounds__(256) k_router(const float* __restrict__ HF, const float* __restrict__ Wr, unsigned* __restrict__ cnt, int* __restrict__ tope, float* __restrict__ topw, int* __restrict__ list) {
    const int lane = threadIdx.x & 63, w = (blockIdx.x * 256 + threadIdx.x) >> 6, nw = (gridDim.x * 256) >> 6;
    for (int m = w; m < MTOK; m += nw) {
        float lg[NEXP];
#pragma unroll
        for (int e = 0; e < NEXP; ++e) lg[e] = 0.f;
        for (int d = lane; d < DM; d += 64) { const float h = HF[(size_t)m * DM + d]; const float4 w0 = ((const float4*)(Wr + (size_t)d * NEXP))[0], w1 = ((const float4*)(Wr + (size_t)d * NEXP))[1];
            lg[0] += h * w0.x; lg[1] += h * w0.y; lg[2] += h * w0.z; lg[3] += h * w0.w; lg[4] += h * w1.x; lg[5] += h * w1.y; lg[6] += h * w1.z; lg[7] += h * w1.w; }
#pragma unroll
        for (int e = 0; e < NEXP; ++e) lg[e] = wave_sum(lg[e]);
        if (lane == 0) {
            int i0 = 0; float b0 = lg[0];
#pragma unroll
            for (int e = 1; e < NEXP; ++e) if (lg[e] > b0) { b0 = lg[e]; i0 = e; }
            int i1 = -1; float b1 = -INFINITY;
#pragma unroll
            for (int e = 0; e < NEXP; ++e) if (e != i0 && lg[e] > b1) { b1 = lg[e]; i1 = e; }
            const float e1 = expf(b1 - b0), w0 = 1.f / (1.f + e1), w1 = e1 / (1.f + e1);
            const unsigned p0 = atomicAdd(&cnt[i0], 1u), p1 = atomicAdd(&cnt[i1], 1u);
            list[i0 * MTOK + p0] = m; list[i1 * MTOK + p1] = m;
            tope[m * 2] = i0 | ((int)p0 << 8); tope[m * 2 + 1] = i1 | ((int)p1 << 8);
            topw[m * 2] = w0; topw[m * 2 + 1] = w1;
        }
    }
}

extern "C" void kernel_launch(void* const* d_in, const int* in_sizes, int n_in, void* d_out, int out_size, void* d_ws, size_t ws_size, hipStream_t stream) {
    (void)in_sizes; (void)n_in; (void)out_size; (void)ws_size;
    const float* x = (const float*)d_in[0];
    const float* ln_in_g = (const float*)d_in[1]; const float* ln_in_b = (const float*)d_in[2];
    const float* w_in = (const float*)d_in[3]; const float* cmp_pos = (const float*)d_in[4]; const float* cmp_w1 = (const float*)d_in[5]; const float* cmp_b1 = (const float*)d_in[6];
    const float* cmp_w2 = (const float*)d_in[7]; const float* cmp_b2 = (const float*)d_in[8]; const float* conv_w = (const float*)d_in[9]; const float* w_o = (const float*)d_in[10];
    const float* ln1_g = (const float*)d_in[11]; const float* ln1_b = (const float*)d_in[12]; const float* ln2_g = (const float*)d_in[13]; const float* ln2_b = (const float*)d_in[14];
    const float* ffn_wg = (const float*)d_in[15]; const float* ffn_wu = (const float*)d_in[16]; const float* ffn_wd = (const float*)d_in[17];
    const float* moe_router = (const float*)d_in[18]; const float* moe_wg = (const float*)d_in[19]; const float* moe_wu = (const float*)d_in[20]; const float* moe_wd = (const float*)d_in[21];
    unsigned char* ws = (unsigned char*)d_ws;
    float* HF = (float*)d_out;
    unsigned* ctl = (unsigned*)(ws + OFF_CTL);
    bf16_t* WIN_T = (bf16_t*)(ws + OFF_WIN_T); bf16_t* WO_T = (bf16_t*)(ws + OFF_WO_T); bf16_t* FGU_T = (bf16_t*)(ws + OFF_FGU_T); bf16_t* FD_T = (bf16_t*)(ws + OFF_FD_T);
    bf16_t* MGU_T = (bf16_t*)(ws + OFF_MGU_T); bf16_t* MD_T = (bf16_t*)(ws + OFF_MD_T);
    bf16_t* HB = (bf16_t*)(ws + OFF_HB); bf16_t* OATT = (bf16_t*)(ws + OFF_OATT); bf16_t* ZQ = (bf16_t*)(ws + OFF_ZQ); bf16_t* ZC = (bf16_t*)(ws + OFF_ZC);
    float* GATES = (float*)(ws + OFF_GATES); float* KC = (float*)(ws + OFF_KC); float* VC = KC + (size_t)BATCH * NG * 128 * HD;
    unsigned* SELM = (unsigned*)(ws + OFF_SELM); int* TOPE = (int*)(ws + OFF_TOPE); float* TOPW = (float*)(ws + OFF_TOPW); int* LIST = (int*)(ws + OFF_LIST);
    bf16_t* ACT = ZQ; float* TMP1 = (float*)ZQ; bf16_t* PO = HB;

    hipMemsetAsync(ws + OFF_CTL, 0, 1u << 20, stream);
    k_zero16<<<256, 256, 0, stream>>>((uint4*)WIN_T, 2 * SZ_WIN_T / 16);
    for (int l = 0; l < DEPTH; ++l) {
        k_transpose_w<<<1024, 256, 0, stream>>>(w_in + (size_t)l * DM * DIN, DM, DIN, WIN_T + (size_t)l * DINP * DM, 1, (DIN + 31) / 32);
        k_transpose_w<<<512, 256, 0, stream>>>(w_o + (size_t)l * DM * DM, DM, DM, WO_T + (size_t)l * DM * DM, 0, DM / 32);
    }
    k_transpose_w<<<1024, 256, 0, stream>>>(ffn_wg, DM, DFF, FGU_T, 2, DFF / 32);
    k_transpose_w<<<1024, 256, 0, stream>>>(ffn_wu, DM, DFF, FGU_T, 3, DFF / 32);
    k_transpose_w<<<1024, 256, 0, stream>>>(ffn_wd, DFF, DM, FD_T, 0, DM / 32);
    for (int e = 0; e < NEXP; ++e) {
        k_transpose_w<<<704, 256, 0, stream>>>(moe_wg + (size_t)e * DM * DFFE, DM, DFFE, MGU_T + (size_t)e * 2 * DFFE * DM, 2, DFFE / 32);
        k_transpose_w<<<704, 256, 0, stream>>>(moe_wu + (size_t)e * DM * DFFE, DM, DFFE, MGU_T + (size_t)e * 2 * DFFE * DM, 3, DFFE / 32);
        k_transpose_w<<<704, 256, 0, stream>>>(moe_wd + (size_t)e * DFFE * DM, DFFE, DM, MD_T + (size_t)e * DM * DFFE, 0, DM / 32);
    }
    { LnArgs a{}; a.X = x; a.g = ln_in_g; a.b = ln_in_b; a.HF = HF; a.HB = HB; k_ln<0><<<1024, 256, 0, stream>>>(a); }
    for (int l = 0; l < DEPTH; ++l) {
        { GArgs a{}; a.A = HB; a.B = WIN_T + (size_t)l * DINP * DM; a.K = DM; a.O0 = ZQ; a.O1 = ZC; a.OF = GATES; k_gemm_naive<0><<<dim3(DINP / 64, MTOK / 64), 256, 0, stream>>>(a); }
        k_compress<<<2048, 256, 0, stream>>>(ZQ, cmp_pos + (size_t)l * 2 * 2048, cmp_w1 + (size_t)l * 2 * 2048 * CMPH, cmp_b1 + (size_t)l * 2 * CMPH, cmp_w2 + (size_t)l * 2 * CMPH * HD, cmp_b2 + (size_t)l * 2 * HD, KC);
        k_attn_naive<<<4096, 256, 0, stream>>>(ZQ, GATES, KC, VC, OATT, SELM);
        k_conv<<<2048, 256, 0, stream>>>(ZC, conv_w + (size_t)l * 3 * 512, OATT);
        { GArgs a{}; a.A = OATT; a.B = WO_T + (size_t)l * DM * DM; a.K = DM; a.OF = TMP1; k_gemm_naive<1><<<dim3(DM / 64, MTOK / 64), 256, 0, stream>>>(a); }
        { LnArgs a{}; a.TMP = TMP1; a.g = ln1_g + l * DM; a.b = ln1_b + l * DM; a.HF = HF; a.HB = HB; k_ln<1><<<1024, 256, 0, stream>>>(a); }
        if (l % 2 == 0) {
            { GArgs a{}; a.A = HB; a.B = FGU_T; a.K = DM; a.O0 = ACT; k_gemm_naive<2><<<dim3(DFF / 64, MTOK / 64), 256, 0, stream>>>(a); }
            { GArgs a{}; a.A = ACT; a.B = FD_T; a.K = DFF; a.O0 = OATT; k_gemm_naive<3><<<dim3(DM / 64, MTOK / 64), 256, 0, stream>>>(a); }
            { LnArgs a{}; a.TMPB = OATT; a.g = ln2_g + l * DM; a.b = ln2_b + l * DM; a.HF = HF; a.HB = HB; k_ln<3><<<1024, 256, 0, stream>>>(a); }
        } else {
            k_router<<<1024, 256, 0, stream>>>(HF, moe_router, ctl + CW_CNT, TOPE, TOPW, LIST);
            { GArgs a{}; a.A = HB; a.B = MGU_T; a.K = DM; a.O0 = ACT; a.cnt = ctl + CW_CNT; a.list = LIST; k_gemm_naive<4><<<dim3(DFFE / 64, NEXP * 256), 256, 0, stream>>>(a); }
            { GArgs a{}; a.A = ACT; a.B = MD_T; a.K = DFFE; a.O0 = PO; a.cnt = ctl + CW_CNT; a.list = LIST; k_gemm_naive<5><<<dim3(DM / 64, NEXP * 256), 256, 0, stream>>>(a); }
            { LnArgs a{}; a.PO = PO; a.tope = TOPE; a.topw = TOPW; a.cnt = ctl + CW_CNT; a.g = ln2_g + l * DM; a.b = ln2_b + l * DM; a.HF = HF; a.HB = HB; k_ln<2><<<1024, 256, 0, stream>>>(a); }
        }
    }
}
```

```cpp
#include <hip/hip_runtime.h>
#include <stdint.h>
#include <math.h>

typedef unsigned short bf16_t;
#define LAS __attribute__((address_space(3)))
#define GAS __attribute__((address_space(1)))

constexpr int DM = 1024, BATCH = 8, SEQ = 2048, DEPTH = 2;
constexpr int MTOK = BATCH * SEQ;
constexpr int NH = 8, NG = 2, HPG = 4, HD = 64;
constexpr int DIN = 2840, DINP = 3072;
constexpr int NCMP = 127, CMPH = 256;
constexpr int DFF = 2816, NEXP = 8, DFFE = 1408;
constexpr int ZQP = 1280;
constexpr int ZCP = 1536;
constexpr int GP = 32;
constexpr float ALPHA = 1.41421356237309515f;
constexpr float LN_EPS = 1e-5f;
constexpr int NWAVES = 8, NTHR = 512;

constexpr size_t OFF_CTL = 0;
constexpr size_t SZ_WIN_T = (size_t)DINP * DM * 2;
constexpr size_t OFF_WIN_T = 1u << 20;
constexpr size_t OFF_CW1_T = OFF_WIN_T + 2 * SZ_WIN_T;
constexpr size_t OFF_WO_T = OFF_CW1_T + 4 * 1048576;
constexpr size_t OFF_FGU_T = OFF_WO_T + 2 * 2097152;
constexpr size_t OFF_FD_T = OFF_FGU_T + (size_t)2 * DFF * DM * 2;
constexpr size_t OFF_MGU_T = OFF_FD_T + (size_t)DM * DFF * 2;
constexpr size_t OFF_MD_T = OFF_MGU_T + (size_t)NEXP * 2 * DFFE * DM * 2;
constexpr size_t OFF_HB = OFF_MD_T + (size_t)NEXP * DM * DFFE * 2;
constexpr size_t OFF_OATT = OFF_HB + (size_t)MTOK * DM * 2;
constexpr size_t OFF_ZQ = OFF_OATT + (size_t)MTOK * DM * 2;
constexpr size_t OFF_ZC = OFF_ZQ + (size_t)MTOK * ZQP * 2;
constexpr size_t OFF_GATES = OFF_ZC + (size_t)MTOK * ZCP * 2;
constexpr size_t OFF_KC = OFF_GATES + (size_t)MTOK * GP * 4;
constexpr size_t OFF_SELM = OFF_KC + 1048576;
constexpr size_t OFF_TOPE = OFF_SELM + 131072;
constexpr size_t OFF_TOPW = OFF_TOPE + 131072;
constexpr size_t OFF_LIST = OFF_TOPW + 131072;
constexpr size_t OFF_XCH = OFF_LIST + 524288;
constexpr size_t WS_END = OFF_XCH + 4 * 524288;
static_assert(WS_END <= 280552448ull, "d_ws map exceeds the guaranteed workspace");
static_assert((size_t)MTOK * DFF * 2 == (size_t)MTOK * (ZQP + ZCP) * 2, "ACT overlays ZQ+ZC exactly");
constexpr int CW_TMO = 0, CW_CODE = 1;
constexpr int CW_CNT = 512;
constexpr int CW_BAR = 4096;
constexpr int CW_SEAM = 16384, SEAM_BANK = 128 * 64;
constexpr size_t CTL_ZERO_BYTES = 1u << 20;
static_assert((CW_SEAM + 4 * SEAM_BANK) * 4 <= (int)CTL_ZERO_BYTES, "CTL words inside the memset region");

constexpr int RING_OFF = 0, RING_BYTES = 131072;
constexpr int LDSCTL_OFF = RING_BYTES, MISC_OFF = LDSCTL_OFF + 320;
constexpr int LDS_BYTES = 147456;

__device__ __forceinline__ float bf2f(bf16_t v) { return __uint_as_float((unsigned)v << 16); }
__device__ __forceinline__ bf16_t f2bf(float f) { unsigned u = __float_as_uint(f); return (bf16_t)((u + 0x7fffu + ((u >> 16) & 1u)) >> 16); }
__device__ __forceinline__ unsigned pk2(float lo, float hi) { return (unsigned)f2bf(lo) | ((unsigned)f2bf(hi) << 16); }
__device__ __forceinline__ float wave_sum(float v) {
#pragma unroll
    for (int o = 32; o > 0; o >>= 1) v += __shfl_xor(v, o);
    return v;
}
__device__ __forceinline__ float wave_max(float v) {
#pragma unroll
    for (int o = 32; o > 0; o >>= 1) v = fmaxf(v, __shfl_xor(v, o));
    return v;
}
namespace pg8 {
#define PG8_LAS __attribute__((address_space(3)))
typedef short bf16x8 __attribute__((ext_vector_type(8)));
typedef float f32x4 __attribute__((ext_vector_type(4)));
typedef float f32x2 __attribute__((ext_vector_type(2)));
typedef unsigned u32x4 __attribute__((ext_vector_type(4)));
typedef unsigned u32x2 __attribute__((ext_vector_type(2)));
constexpr int BM = 256, BK = 64, HALF = 128, HTB = HALF * BK * 2  , STAGE_BYTES = 8 * HTB, NXCD = 8, WGM = 8;

__host__ __device__ __forceinline__ int lds_byte(int r, int c) { const int st = (r >> 4) * 2 + (c >> 5), rr = r & 15, cc = c & 31, ob = rr * 64 + cc * 2; return st * 1024 + (ob ^ (((ob >> 9) & 1) << 5)); }
__host__ __device__ __forceinline__ void stage_rc(int b, int& R, int& C) { const int st = b / 1024, sb = b % 1024, swz = sb ^ (((sb >> 9) & 1) << 5); R = (st >> 1) * 16 + swz / 64; C = (st & 1) * 32 + (swz % 64) / 2; }
__host__ __device__ __forceinline__ int perm32(int rho) { const int n = rho >> 4, i = rho & 15; return 8 * (i >> 2) + 4 * n + (i & 3); }

struct Unit { int pm, pn; };

struct StaticOrder {
    int nM, nN, nwg, G, c;
    __host__ __device__ void init(int nM_, int nN_, int G_, int c_) { nM = nM_; nN = nN_; nwg = nM * nN; G = G_; c = c_; }
    __host__ __device__ bool next(int i, Unit& u) const {
        const long L = (long)i * G + c; if (L >= nwg) return false;
        int wgid = (int)L; { const int q = nwg / NXCD, r = nwg % NXCD, xcd = wgid % NXCD, off = wgid / NXCD; wgid = (xcd < r ? xcd * (q + 1) : r * (q + 1) + (xcd - r) * q) + off; }
        const int nig = WGM * nN, gid = wgid / nig, fm = gid * WGM, gsz = (nM - fm) < WGM ? (nM - fm) : WGM;
        u.pm = fm + ((wgid % nig) % gsz); u.pn = (wgid % nig) / gsz; return true;
    }
};

struct APlain {
    const char* A; unsigned row_bytes;
    __device__ __forceinline__ const char* base(int pm, int h) const { return A + (size_t)(pm * BM + h * HALF) * row_bytes; }
    __device__ __forceinline__ size_t kstep() const { return (size_t)BK * 2; }
    __device__ __forceinline__ unsigned voff(int R, int C) const { return (unsigned)R * row_bytes + (unsigned)C * 2u; }
};

__device__ __forceinline__ unsigned cvt_pk_bf16(float lo, float hi) { unsigned r; asm volatile("v_cvt_pk_bf16_f32 %0, %1, %2" : "=v"(r) : "v"(lo), "v"(hi)); return r; }

struct EpiF32 {
    static constexpr bool PERM = false, AFTER_DRAIN = false;
    float* C; int ldc;
    __device__ __forceinline__ void operator()(const f32x4 (&acc)[2][2][4][2], const Unit& u, int wr, int wc, int fr, int fq) const {
        const int row0 = u.pm * BM + wr * 64 + fr, col0 = u.pn * BM + wc * 32 + 4 * fq;
#pragma unroll
        for (int ai = 0; ai < 2; ++ai)
#pragma unroll
            for (int m = 0; m < 4; ++m) { float* rowp = C + (size_t)(row0 + ai * HALF + m * 16) * ldc + col0;
#pragma unroll
                for (int bj = 0; bj < 2; ++bj)
#pragma unroll
                    for (int n = 0; n < 2; ++n) *(f32x4*)(rowp + bj * HALF + n * 16) = acc[ai][bj][m][n]; }
    }
};
struct EpiBf16 {
    static constexpr bool PERM = true, AFTER_DRAIN = false;
    bf16_t* O; int ldc;
    __device__ __forceinline__ void operator()(const f32x4 (&acc)[2][2][4][2], const Unit& u, int wr, int wc, int fr, int fq) const {
        const int row0 = u.pm * BM + wr * 64 + fr, col0 = u.pn * BM + wc * 32 + 8 * fq;
#pragma unroll
        for (int ai = 0; ai < 2; ++ai)
#pragma unroll
            for (int m = 0; m < 4; ++m) { bf16_t* rowp = O + (size_t)(row0 + ai * HALF + m * 16) * ldc + col0;
#pragma unroll
                for (int bj = 0; bj < 2; ++bj) { const f32x4 v0 = acc[ai][bj][m][0], v1 = acc[ai][bj][m][1];
                    u32x4 w; w.x = cvt_pk_bf16(v0[0], v0[1]); w.y = cvt_pk_bf16(v0[2], v0[3]); w.z = cvt_pk_bf16(v1[0], v1[1]); w.w = cvt_pk_bf16(v1[2], v1[3]);
                    *(u32x4*)(rowp + bj * HALF) = w; } }
    }
};
struct EpiWin {
    static constexpr bool PERM = true, AFTER_DRAIN = false;
    bf16_t* ZQ; bf16_t* ZC; float* GATES;
    __device__ __forceinline__ void operator()(const f32x4 (&acc)[2][2][4][2], const Unit& u, int wr, int wc, int fr, int fq) const {
        const int row0 = u.pm * BM + wr * 64 + fr;
        if (u.pn < 11) {
            bf16_t* base; int pitch, colt;
            if (u.pn < 5) { base = ZQ; pitch = ZQP; colt = u.pn * BM; } else { base = ZC; pitch = ZCP; colt = (u.pn - 5) * BM; }
            const int col0 = colt + wc * 32 + 8 * fq;
#pragma unroll
            for (int ai = 0; ai < 2; ++ai)
#pragma unroll
                for (int m = 0; m < 4; ++m) { bf16_t* rowp = base + (size_t)(row0 + ai * HALF + m * 16) * pitch + col0;
#pragma unroll
                    for (int bj = 0; bj < 2; ++bj) { const f32x4 v0 = acc[ai][bj][m][0], v1 = acc[ai][bj][m][1];
                        u32x4 w; w.x = cvt_pk_bf16(v0[0], v0[1]); w.y = cvt_pk_bf16(v0[2], v0[3]); w.z = cvt_pk_bf16(v1[0], v1[1]); w.w = cvt_pk_bf16(v1[2], v1[3]);
                        *(u32x4*)(rowp + bj * HALF) = w; } }
        } else if (wc == 0 && fq < 3) {
#pragma unroll
            for (int ai = 0; ai < 2; ++ai)
#pragma unroll
                for (int m = 0; m < 4; ++m) { float* gp = GATES + (size_t)(row0 + ai * HALF + m * 16) * GP + 8 * fq;
                    *(f32x4*)(gp) = acc[ai][0][m][0]; *(f32x4*)(gp + 4) = acc[ai][0][m][1]; }
        }
    }
};
__device__ __forceinline__ float silu_mul(float g, float u) { return g * __builtin_amdgcn_rcpf(1.0f + __builtin_amdgcn_exp2f(-1.4426950408889634f * g)) * u; }
struct EpiSwiglu {
    static constexpr bool PERM = true, AFTER_DRAIN = false;
    bf16_t* O; int ldc;
    __device__ __forceinline__ void operator()(const f32x4 (&acc)[2][2][4][2], const Unit& u, int wr, int wc, int fr, int fq) const {
        const int row0 = u.pm * BM + wr * 64 + fr, col0 = u.pn * HALF + wc * 32 + 8 * fq;
#pragma unroll
        for (int ai = 0; ai < 2; ++ai)
#pragma unroll
            for (int m = 0; m < 4; ++m) { bf16_t* rowp = O + (size_t)(row0 + ai * HALF + m * 16) * ldc + col0;
                const f32x4 g0 = acc[ai][0][m][0], g1 = acc[ai][0][m][1], u0 = acc[ai][1][m][0], u1 = acc[ai][1][m][1];
                u32x4 w; w.x = cvt_pk_bf16(silu_mul(g0[0], u0[0]), silu_mul(g0[1], u0[1])); w.y = cvt_pk_bf16(silu_mul(g0[2], u0[2]), silu_mul(g0[3], u0[3]));
                w.z = cvt_pk_bf16(silu_mul(g1[0], u1[0]), silu_mul(g1[1], u1[1])); w.w = cvt_pk_bf16(silu_mul(g1[2], u1[2]), silu_mul(g1[3], u1[3]));
                *(u32x4*)rowp = w; }
    }
};

template <class Epi, class AP, class Sched, bool ALIGN_EPI>
__device__ __forceinline__ void gemm_phase(PG8_LAS unsigned char* lds, const AP ap, const bf16_t* Bt, const int K, const Sched& S, const Epi& E, const int tid) {
    const int wid = __builtin_amdgcn_readfirstlane(tid >> 6), lane = tid & 63, wr = wid >> 2, wc = wid & 3, fr = lane & 15, fq = lane >> 4;
    const int nt = K / BK;
    unsigned voffA[2], voffB[2];
#pragma unroll
    for (int i = 0; i < 2; ++i) { int R, C; stage_rc(tid * 16 + i * 8192, R, C); const int Rb = Epi::PERM ? ((R & ~31) + perm32(R & 31)) : R;
        voffA[i] = ap.voff(R, C); voffB[i] = (unsigned)(Rb * K + C) * 2u; }
    const size_t kstepA = ap.kstep();
    const size_t kstepB = (size_t)(BK * 2);
    const size_t hstepB = (size_t)HALF * K * 2;
    const size_t tstepB = 2 * hstepB;
    const unsigned ldsw = (unsigned)wid * 1024u;
    const int aoff = lds_byte(wr * 64 + fr, fq * 8), boff = lds_byte(wc * 32 + fr, fq * 8);
#define PG8_SA(b, h) (((b) * 2 + (h)) * HTB)
#define PG8_SB(b, h) ((4 + (b) * 2 + (h)) * HTB)
#define PG8_STAGE(bufoff, gbase, voff) do { _Pragma("unroll") for (int _i = 0; _i < 2; ++_i) \
        __builtin_amdgcn_global_load_lds((const unsigned*)((const char*)(gbase) + (voff)[_i]), (PG8_LAS unsigned*)(lds + (bufoff) + ldsw + _i * 8192), 16, 0, 0); } while (0)
#define PG8_LDA(dst, b, h) do { _Pragma("unroll") for (int m = 0; m < 4; ++m) _Pragma("unroll") for (int k = 0; k < 2; ++k) dst[m][k] = *(const PG8_LAS bf16x8*)(lds + PG8_SA(b, h) + aoff + m * 2048 + k * 1024); } while (0)
#define PG8_LDB(dst, b, h) do { _Pragma("unroll") for (int n = 0; n < 2; ++n) _Pragma("unroll") for (int k = 0; k < 2; ++k) dst[n][k] = *(const PG8_LAS bf16x8*)(lds + PG8_SB(b, h) + boff + n * 2048 + k * 1024); } while (0)
#define PG8_MMA(ai, bj, At, Bt_) do { __builtin_amdgcn_s_setprio(1); _Pragma("unroll") for (int m = 0; m < 4; ++m) _Pragma("unroll") for (int n = 0; n < 2; ++n) _Pragma("unroll") for (int k = 0; k < 2; ++k) \
        acc[ai][bj][m][n] = __builtin_amdgcn_mfma_f32_16x16x32_bf16(Bt_[n][k], At[m][k], acc[ai][bj][m][n], 0, 0, 0); __builtin_amdgcn_s_setprio(0); } while (0)
#define PG8_WAIT_V(n) asm volatile("s_waitcnt vmcnt(" #n ")" ::: "memory")
#define PG8_WAIT_L(n) asm volatile("s_waitcnt lgkmcnt(" #n ")" ::: "memory")
#define PG8_BAR __builtin_amdgcn_s_barrier()
#define PG8_SCHED __builtin_amdgcn_sched_barrier(0)
    Unit cur, nxt; int ui = 0;
    if (!S.next(0, cur)) return;
    f32x4 acc[2][2][4][2];
#pragma unroll
    for (int a = 0; a < 2; ++a)
#pragma unroll
        for (int b = 0; b < 2; ++b)
#pragma unroll
            for (int m = 0; m < 4; ++m)
#pragma unroll
                for (int n = 0; n < 2; ++n) acc[a][b][m][n] = (f32x4){0.f, 0.f, 0.f, 0.f};
    bf16x8 At[4][2], B0[2][2], B1[2][2];
    const char* cA0 = ap.base(cur.pm, 0); const char* cA1 = ap.base(cur.pm, 1); const char* cB = (const char*)Bt + (size_t)cur.pn * tstepB;
    PG8_STAGE(PG8_SB(0, 0), cB, voffB); PG8_STAGE(PG8_SB(0, 1), cB + hstepB, voffB); PG8_STAGE(PG8_SA(0, 0), cA0, voffA); PG8_STAGE(PG8_SA(0, 1), cA1, voffA);
    if (wr == 1) PG8_BAR;
    PG8_WAIT_V(2); PG8_BAR;
    PG8_STAGE(PG8_SB(1, 0), cB + kstepB, voffB); PG8_STAGE(PG8_SA(1, 0), cA0 + kstepA, voffA); PG8_STAGE(PG8_SB(1, 1), cB + hstepB + kstepB, voffB);
    PG8_WAIT_V(6); PG8_BAR;
    for (;;) {
        const bool has_next = S.next(ui + 1, nxt);
        const char* nA0 = has_next ? ap.base(nxt.pm, 0) : cA0; const char* nA1 = has_next ? ap.base(nxt.pm, 1) : cA1;
        const char* nB = has_next ? (const char*)Bt + (size_t)nxt.pn * tstepB : cB;
        for (int t = 0; t < nt; t += 2) {
            const bool last = (t == nt - 2);
            const char* a1_1 = cA1 + (size_t)(t + 1) * kstepA;
            const char* a2_0 = last ? nA0 : cA0 + (size_t)(t + 2) * kstepA; const char* a2_1 = last ? nA1 : cA1 + (size_t)(t + 2) * kstepA;
            const char* b2 = last ? nB : cB + (size_t)(t + 2) * kstepB;
            const char* a3_0 = a2_0 + kstepA; const char* b3 = b2 + kstepB;
            PG8_LDB(B0, 0, 0); PG8_LDB(B1, 0, 1); PG8_SCHED; PG8_LDA(At, 0, 0); PG8_STAGE(PG8_SA(1, 1), a1_1, voffA);
            PG8_WAIT_V(8); PG8_WAIT_L(0); PG8_BAR; PG8_MMA(0, 0, At, B0); PG8_MMA(0, 1, At, B1); PG8_BAR; PG8_SCHED;
            PG8_LDA(At, 0, 1); PG8_STAGE(PG8_SB(0, 0), b2, voffB); PG8_STAGE(PG8_SB(0, 1), b2 + hstepB, voffB); PG8_STAGE(PG8_SA(0, 0), a2_0, voffA);
            PG8_WAIT_V(8); PG8_WAIT_L(0); PG8_BAR; PG8_MMA(1, 0, At, B0); PG8_MMA(1, 1, At, B1); PG8_BAR; PG8_SCHED;
            PG8_LDB(B0, 1, 0); PG8_LDB(B1, 1, 1); PG8_SCHED; PG8_LDA(At, 1, 0); PG8_STAGE(PG8_SA(0, 1), a2_1, voffA);
            PG8_WAIT_V(8); PG8_WAIT_L(0); PG8_BAR; PG8_MMA(0, 0, At, B0); PG8_MMA(0, 1, At, B1); PG8_BAR; PG8_SCHED;
            PG8_LDA(At, 1, 1); PG8_STAGE(PG8_SB(1, 0), b3, voffB); PG8_STAGE(PG8_SB(1, 1), b3 + hstepB, voffB); PG8_STAGE(PG8_SA(1, 0), a3_0, voffA);
            PG8_WAIT_V(8); PG8_WAIT_L(0); PG8_BAR; PG8_MMA(1, 0, At, B0); PG8_MMA(1, 1, At, B1); PG8_BAR; PG8_SCHED;
        }
        if constexpr (ALIGN_EPI) { if (wr == 0) PG8_BAR; }
        if constexpr (!Epi::AFTER_DRAIN) { E(acc, cur, wr, wc, fr, fq); }
        if (!has_next) break;
#pragma unroll
        for (int a = 0; a < 2; ++a)
#pragma unroll
            for (int b = 0; b < 2; ++b)
#pragma unroll
                for (int m = 0; m < 4; ++m)
#pragma unroll
                    for (int n = 0; n < 2; ++n) acc[a][b][m][n] = (f32x4){0.f, 0.f, 0.f, 0.f};
        cur = nxt; cA0 = nA0; cA1 = nA1; cB = nB; ++ui;
        if constexpr (ALIGN_EPI) { if (wr == 1) PG8_BAR; }
    }
    PG8_WAIT_V(0);
    if constexpr (!ALIGN_EPI) { if (wr == 0) PG8_BAR; }
    PG8_BAR;
    if constexpr (Epi::AFTER_DRAIN) { E.fused(acc, cur, wr, wc, fr, fq, lds, wid, lane); }
#undef PG8_SA
#undef PG8_SB
#undef PG8_STAGE
#undef PG8_LDA
#undef PG8_LDB
#undef PG8_MMA
#undef PG8_WAIT_V
#undef PG8_WAIT_L
#undef PG8_BAR
#undef PG8_SCHED
}
}
#define XB_TMO      128
#define XB_XCNT(j)  (256  + 64 * (j))
#define XB_XSUB(j)  (1280 + 64 * (j))
#define XB_XGEN(j)  (2304 + 64 * (j))
#define XB_TOP      3328
#define XB_TOPGEN   3392
#define XCD_BAR_WORDS 3456
#define XB_SPIN_CAP (1u << 18)

__device__ __forceinline__ unsigned xb_ld(unsigned* p)              { return __hip_atomic_load(p, __ATOMIC_RELAXED, __HIP_MEMORY_SCOPE_AGENT); }
__device__ __forceinline__ unsigned xb_add(unsigned* p, unsigned v) { return __hip_atomic_fetch_add(p, v, __ATOMIC_RELAXED, __HIP_MEMORY_SCOPE_AGENT); }
__device__ __forceinline__ unsigned xb_xcc_id() { return (unsigned)__builtin_amdgcn_s_getreg((3 << 11) | 20) & 0xFu; }
#define XB_SPIN(cond, bar) do { unsigned _sp = 0; while (cond) { __builtin_amdgcn_s_sleep(1); \
    if ((++_sp & 255u) == 0u) { if (xb_ld(&(bar)[XB_TMO])) break; if (_sp > XB_SPIN_CAP) { atomicAdd(&(bar)[XB_TMO], 1u); break; } } } } while (0)

struct XcdBarrier {
    unsigned* bar; unsigned x;
    volatile LAS unsigned* st;
};

__device__ __forceinline__ XcdBarrier xcd_barrier_post(unsigned* bar, volatile LAS unsigned* st) {
    XcdBarrier b; b.bar = bar; b.x = xb_xcc_id(); b.st = st;
    if (threadIdx.x == 0) (void)xb_add(&bar[XB_XCNT(b.x)], 1u);
    return b;
}
__device__ __forceinline__ void xcd_barrier_complete(unsigned* bar, unsigned x, unsigned& nloc, unsigned& nx) {
    const unsigned G = gridDim.x * gridDim.y * gridDim.z;
    unsigned sum, cnt, mine, sp = 0u;
    for (;;) {
        sum = 0u; cnt = 0u; mine = 0u;
#pragma unroll
        for (unsigned j = 0; j < 16; ++j) { const unsigned c = xb_ld(&bar[XB_XCNT(j)]); sum += c; cnt += (c > 0u) ? 1u : 0u; mine = (j == x) ? c : mine; }
        if (sum == G) break;
        __builtin_amdgcn_s_sleep(1);
        if ((++sp & 255u) == 0u) { if (xb_ld(&bar[XB_TMO])) break; if (sp > XB_SPIN_CAP) { atomicAdd(&bar[XB_TMO], 1u); break; } }
    }
    nloc = mine > 0u ? mine : 1u; nx = cnt > 0u ? cnt : 1u;
}

__device__ __forceinline__ void xcd_barrier(const XcdBarrier& b) {
    asm volatile("s_waitcnt vmcnt(0)" ::: "memory");
    __syncthreads();
    if (threadIdx.x == 0) {
        unsigned* bar = b.bar;
        __builtin_amdgcn_s_waitcnt(0);
        unsigned nloc = b.st[0], nx = b.st[1];
        if (nloc == 0u) { xcd_barrier_complete(bar, b.x, nloc, nx); b.st[0] = nloc; b.st[1] = nx; }
        const unsigned old = xb_add(&bar[XB_XSUB(b.x)], 1u);
        const unsigned gen = old / nloc;
        if (old + 1u == (gen + 1u) * nloc) {
            __builtin_amdgcn_fence(__ATOMIC_RELEASE, "agent");
            asm volatile("s_waitcnt vmcnt(0)" ::: "memory");
            const unsigned og = xb_add(&bar[XB_TOP], 1u);
            const unsigned tg = og / nx;
            if (og + 1u == (tg + 1u) * nx) xb_add(&bar[XB_TOPGEN], 1u);
            else XB_SPIN(xb_ld(&bar[XB_TOPGEN]) == tg, bar);
            __builtin_amdgcn_fence(__ATOMIC_ACQUIRE, "agent");
            xb_add(&bar[XB_XGEN(b.x)], 1u);
            asm volatile("s_waitcnt vmcnt(0)" ::: "memory");
        } else {
            XB_SPIN(xb_ld(&bar[XB_XGEN(b.x)]) == gen, bar);
            __builtin_amdgcn_fence(__ATOMIC_ACQUIRE, "agent");
            asm volatile("s_waitcnt vmcnt(0)" ::: "memory");
        }
    }
    __syncthreads();
}

struct Args { const float* in[22]; float* out; unsigned char* ws; int ph_lo, ph_hi; };
struct Frame {
    LAS unsigned char* lds; unsigned char* ldsg;
    volatile LAS unsigned* MISC;
    unsigned* ctl;
    int tid, lane, wave, vcu, G;
};
#define LDS_WAIT() asm volatile("s_waitcnt lgkmcnt(0)" ::: "memory")

__device__ __forceinline__ int map_row(int n, int mode) {
    if (mode == 1) return n < 1280 ? n : (n < 1304 ? 2816 + (n - 1280) : 1280 + (n - 1304));
    if (mode == 2) return (n >> 7) * 256 + (n & 127);
    if (mode == 3) return (n >> 7) * 256 + 128 + (n & 127);
    return n;
}
__device__ __forceinline__ void p0_transpose_item(const float* W, int K, int N, bf16_t* WT, int mode, LAS float* scr, int item, int lane) {
    const int nblk = (N + 31) / 32, kb = item / nblk, nb = item % nblk, k0 = 64 * kb, n0 = 32 * nb;
    const int nl = n0 + (lane & 31); const bool okl = nl < N;
#pragma unroll 8
    for (int i = 0; i < 32; ++i) { const int kk = 2 * i + (lane >> 5); scr[kk * 33 + (lane & 31)] = okl ? W[(size_t)(k0 + kk) * N + nl] : 0.f; }
    LDS_WAIT(); asm volatile("" ::: "memory");
    const int c = lane & 7;
#pragma unroll
    for (int j = 0; j < 4; ++j) { const int n = (lane >> 3) + 8 * j; const LAS float* s = scr + (8 * c) * 33 + n;
        uint4 o; o.x = pk2(s[0 * 33], s[1 * 33]); o.y = pk2(s[2 * 33], s[3 * 33]); o.z = pk2(s[4 * 33], s[5 * 33]); o.w = pk2(s[6 * 33], s[7 * 33]);
        if (n0 + n < N) *(uint4*)(WT + (size_t)map_row(n0 + n, mode) * K + k0 + 8 * c) = o; }
    LDS_WAIT(); asm volatile("" ::: "memory");
}
struct LnP { const float* X; const float* TMP; const bf16_t* TMPB; const bf16_t* PO; const int* tope; const float* topw; const unsigned* cnt; const float* g; const float* b; float* HF; bf16_t* HB; };
template <int MODE> __device__ __forceinline__ void ln_row(const LnP& a, int m, int lane, float4 (&o)[4]) {
    float4 v[4];
    if (MODE == 0) {
#pragma unroll
        for (int j = 0; j < 4; ++j) v[j] = ((const float4*)(a.X + (size_t)m * DM))[64 * j + lane];
    } else {
#pragma unroll
        for (int j = 0; j < 4; ++j) { float4 h = ((const float4*)(a.HF + (size_t)m * DM))[64 * j + lane]; v[j] = make_float4(ALPHA * h.x, ALPHA * h.y, ALPHA * h.z, ALPHA * h.w); }
        if (MODE == 1) {
#pragma unroll
            for (int j = 0; j < 4; ++j) { float4 t = ((const float4*)(a.TMP + (size_t)m * DM))[64 * j + lane]; v[j].x += t.x; v[j].y += t.y; v[j].z += t.z; v[j].w += t.w; }
        } else if (MODE == 3) {
            const bf16_t* row = a.TMPB + (size_t)m * DM;
#pragma unroll
            for (int j = 0; j < 4; ++j) { const uint2 t = ((const uint2*)row)[64 * j + lane];
                v[j].x += bf2f((bf16_t)(t.x & 0xffff)); v[j].y += bf2f((bf16_t)(t.x >> 16)); v[j].z += bf2f((bf16_t)(t.y & 0xffff)); v[j].w += bf2f((bf16_t)(t.y >> 16)); }
        } else {
            int pre[NEXP]; int acc = 0;
#pragma unroll
            for (int e = 0; e < NEXP; ++e) { pre[e] = acc; acc += (int)a.cnt[e]; }
#pragma unroll
            for (int k = 0; k < 2; ++k) {
                const int ep = a.tope[m * 2 + k], e = ep & 255, pos = ep >> 8; const float wk = a.topw[m * 2 + k];
                int p = pos;
#pragma unroll
                for (int e2 = 0; e2 < NEXP; ++e2) if (e2 == e) p += pre[e2];
                const bf16_t* row = a.PO + (size_t)p * DM;
#pragma unroll
                for (int j = 0; j < 4; ++j) { const uint2 t = ((const uint2*)row)[64 * j + lane];
                    v[j].x += wk * bf2f((bf16_t)(t.x & 0xffff)); v[j].y += wk * bf2f((bf16_t)(t.x >> 16)); v[j].z += wk * bf2f((bf16_t)(t.y & 0xffff)); v[j].w += wk * bf2f((bf16_t)(t.y >> 16)); }
            }
        }
    }
    float s = 0.f;
#pragma unroll
    for (int j = 0; j < 4; ++j) s += (v[j].x + v[j].y) + (v[j].z + v[j].w);
    const float mean = wave_sum(s) * (1.f / DM);
    float q = 0.f;
#pragma unroll
    for (int j = 0; j < 4; ++j) { v[j].x -= mean; v[j].y -= mean; v[j].z -= mean; v[j].w -= mean; q += (v[j].x * v[j].x + v[j].y * v[j].y) + (v[j].z * v[j].z + v[j].w * v[j].w); }
    const float rstd = 1.0f / sqrtf(wave_sum(q) * (1.f / DM) + LN_EPS);
#pragma unroll
    for (int j = 0; j < 4; ++j) {
        const float4 g = ((const float4*)a.g)[64 * j + lane], b = ((const float4*)a.b)[64 * j + lane];
        o[j] = make_float4(v[j].x * rstd * g.x + b.x, v[j].y * rstd * g.y + b.y, v[j].z * rstd * g.z + b.z, v[j].w * rstd * g.w + b.w);
        ((float4*)(a.HF + (size_t)m * DM))[64 * j + lane] = o[j];
        if (MODE != 2) { uint2 pk; pk.x = pk2(o[j].x, o[j].y); pk.y = pk2(o[j].z, o[j].w); ((uint2*)(a.HB + (size_t)m * DM))[64 * j + lane] = pk; }
    }
}
__device__ __forceinline__ void route_row(const float4 (&o)[4], int m, int lane, const float* Wr, unsigned* cnt, int* tope, float* topw, int* list) {
    float lg[NEXP];
#pragma unroll
    for (int e = 0; e < NEXP; ++e) lg[e] = 0.f;
#pragma unroll
    for (int j = 0; j < 4; ++j) {
        const float hv[4] = {o[j].x, o[j].y, o[j].z, o[j].w};
#pragma unroll
        for (int i = 0; i < 4; ++i) { const int d = 256 * j + 4 * lane + i; const float4 w0 = ((const float4*)(Wr + (size_t)d * NEXP))[0], w1 = ((const float4*)(Wr + (size_t)d * NEXP))[1];
            lg[0] += hv[i] * w0.x; lg[1] += hv[i] * w0.y; lg[2] += hv[i] * w0.z; lg[3] += hv[i] * w0.w; lg[4] += hv[i] * w1.x; lg[5] += hv[i] * w1.y; lg[6] += hv[i] * w1.z; lg[7] += hv[i] * w1.w; }
    }
#pragma unroll
    for (int e = 0; e < NEXP; ++e) lg[e] = wave_sum(lg[e]);
    if (lane == 0) {
        int i0 = 0; float b0 = lg[0];
#pragma unroll
        for (int e = 1; e < NEXP; ++e) if (lg[e] > b0) { b0 = lg[e]; i0 = e; }
        int i1 = -1; float b1 = -INFINITY;
#pragma unroll
        for (int e = 0; e < NEXP; ++e) if (e != i0 && lg[e] > b1) { b1 = lg[e]; i1 = e; }
        const float e1 = expf(b1 - b0), w0 = 1.f / (1.f + e1), w1 = e1 / (1.f + e1);
        const unsigned p0 = atomicAdd(&cnt[i0], 1u), p1 = atomicAdd(&cnt[i1], 1u);
        list[i0 * MTOK + p0] = m; list[i1 * MTOK + p1] = m;
        tope[m * 2] = i0 | ((int)p0 << 8); tope[m * 2 + 1] = i1 | ((int)p1 << 8);
        topw[m * 2] = w0; topw[m * 2 + 1] = w1;
    }
}

__device__ __forceinline__ void compress_items(const Frame& F, const bf16_t* ZQ, const float* pos, const float* w1, const float* b1, const float* w2, const float* b2, float* KC) {
    const int hb = F.tid >> 8, t256 = F.tid & 255;
    float* win = (float*)(F.ldsg + hb * 16384); float* hid = win + 2048;
    constexpr int NIT = 2 * BATCH * NG * 128;
    for (int base = F.vcu * 2; base < NIT; base += 2 * F.G) {
        const int item = base + hb;
        const int i = item & 127, bg = (item >> 7) % (BATCH * NG), kv = item / (128 * BATCH * NG);
        const int b = bg / NG, g = bg % NG;
        __syncthreads();
        if (i < NCMP) for (int k = t256; k < 2048; k += 256) { const int r = k >> 6, d = k & 63;
            win[k] = bf2f(ZQ[(size_t)(b * SEQ + 16 * i + r) * ZQP + 512 + kv * 128 + g * 64 + d]) + pos[kv * 2048 + k]; }
        __syncthreads();
        if (i < NCMP) {
            float acc = b1[kv * CMPH + t256];
            const float* w = w1 + (size_t)kv * 2048 * CMPH + t256;
            for (int k = 0; k < 2048; ++k) acc += win[k] * w[(size_t)k * CMPH];
            const float x = acc;
            hid[t256] = 0.5f * x * (1.f + tanhf(0.7978845608028654f * (x + 0.044715f * x * x * x)));
        }
        __syncthreads();
        if (t256 < 64) { float o = 0.f;
            if (i < NCMP) { o = b2[kv * HD + t256]; const float* ww = w2 + (size_t)kv * CMPH * HD + t256; for (int n = 0; n < CMPH; ++n) o += hid[n] * ww[n * HD]; }
            KC[((size_t)(kv * BATCH * NG + bg) * 128 + i) * HD + t256] = o; }
    }
}
__device__ __forceinline__ void conv_items(const Frame& F, const bf16_t* ZC, const float* cw, bf16_t* OATT) {
    for (size_t idx = (size_t)F.vcu * NTHR + F.tid; idx < (size_t)MTOK * 512; idx += (size_t)F.G * NTHR) {
        const int ch = (int)(idx & 511); const size_t m = idx >> 9; const int t = (int)(m % SEQ);
        float y = 0.f;
#pragma unroll
        for (int i = 0; i < 3; ++i) { const int dt = 2 - i; if (t - dt >= 0) { const bf16_t* r = ZC + (m - dt) * ZCP; y += bf2f(r[1024 + ch]) * bf2f(r[ch]) * cw[i * 512 + ch]; } }
        OATT[m * DM + 512 + ch] = f2bf(bf2f(ZC[m * ZCP + 512 + ch]) * y);
    }
}

__device__ __forceinline__ float dot64_bf(const float (&q)[64], const bf16_t* kr) {
    float s = 0.f;
#pragma unroll
    for (int c = 0; c < 8; ++c) { const uint4 v = ((const uint4*)kr)[c];
        s += q[8 * c + 0] * __uint_as_float(v.x << 16) + q[8 * c + 1] * __uint_as_float(v.x & 0xffff0000u) + q[8 * c + 2] * __uint_as_float(v.y << 16) + q[8 * c + 3] * __uint_as_float(v.y & 0xffff0000u)
           + q[8 * c + 4] * __uint_as_float(v.z << 16) + q[8 * c + 5] * __uint_as_float(v.z & 0xffff0000u) + q[8 * c + 6] * __uint_as_float(v.w << 16) + q[8 * c + 7] * __uint_as_float(v.w & 0xffff0000u); }
    return s;
}
__device__ __forceinline__ float dot64_f(const float (&q)[64], const float* kr) {
    float s = 0.f;
#pragma unroll
    for (int c = 0; c < 16; ++c) { const float4 v = ((const float4*)kr)[c]; s += q[4 * c] * v.x + q[4 * c + 1] * v.y + q[4 * c + 2] * v.z + q[4 * c + 3] * v.w; }
    return s;
}
__device__ __forceinline__ void online_block(float s, bool valid, const bf16_t* vcol, int vstride, float& m, float& l, float& o) {
    const float sv = valid ? s : -INFINITY;
    const float bm = wave_max(sv);
    if (bm == -INFINITY) return;
    const float mn = fmaxf(m, bm);
    const float sc = expf(m - mn);
    const float p = valid ? expf(s - mn) : 0.f;
    l = l * sc + wave_sum(p);
    o *= sc;
    for (int k = 0; k < 64; ++k) { const float pk = __shfl(p, k); o += pk * bf2f(vcol[(size_t)k * vstride]); }
    m = mn;
}
__device__ __forceinline__ void attn_items(const Frame& F, const bf16_t* ZQ, const float* GATES, const float* KC, const float* VC, bf16_t* OATT, unsigned* SELM) {
    const int lane = F.lane, hb = F.wave >> 2, j = F.wave & 3;
    float (*pl)[128] = (float (*)[128])(F.ldsg + hb * 2048);
    for (int base = F.vcu * 2; base < MTOK * NG; base += 2 * F.G) {
        const int item = base + hb;
        const int g = item % NG; const int m = item / NG; const int b = m / SEQ, t = m % SEQ; const int head = g * HPG + j;
        const bf16_t* zrow = ZQ + (size_t)m * ZQP;
        float q[64];
#pragma unroll
        for (int c = 0; c < 8; ++c) { const uint4 v = ((const uint4*)(zrow + head * HD))[c];
            q[8 * c + 0] = __uint_as_float(v.x << 16); q[8 * c + 1] = __uint_as_float(v.x & 0xffff0000u); q[8 * c + 2] = __uint_as_float(v.y << 16); q[8 * c + 3] = __uint_as_float(v.y & 0xffff0000u);
            q[8 * c + 4] = __uint_as_float(v.z << 16); q[8 * c + 5] = __uint_as_float(v.z & 0xffff0000u); q[8 * c + 6] = __uint_as_float(v.w << 16); q[8 * c + 7] = __uint_as_float(v.w & 0xffff0000u); }
        const bf16_t* zb = ZQ + (size_t)b * SEQ * ZQP;
        const float* kc = KC + (size_t)(b * NG + g) * 128 * HD; const float* vc = VC + (size_t)(b * NG + g) * 128 * HD;
        const int n0 = lane, n1 = lane + 64;
        const bool v0 = (16 * n0 + 31 <= t), v1 = (n1 < NCMP) && (16 * n1 + 31 <= t);
        const float s0 = dot64_f(q, kc + n0 * HD) * 0.125f, s1 = dot64_f(q, kc + n1 * HD) * 0.125f;
        const float mx = wave_max(fmaxf(v0 ? s0 : -INFINITY, v1 ? s1 : -INFINITY));
        float p0 = 0.f, p1 = 0.f;
        if (mx != -INFINITY) { p0 = v0 ? expf(s0 - mx) : 0.f; p1 = v1 ? expf(s1 - mx) : 0.f; const float inv = 1.f / wave_sum(p0 + p1); p0 *= inv; p1 *= inv; }
        __syncthreads();
        pl[j][n0] = p0; pl[j][n1] = p1;
        float ocmp = 0.f;
        for (int n = 0; n < 64; ++n) ocmp += __shfl(p0, n) * vc[n * HD + lane];
        for (int n = 0; n < 63; ++n) ocmp += __shfl(p1, n) * vc[(64 + n) * HD + lane];
        __syncthreads();
        unsigned mask;
        {
            const int jj = lane & 31; float imp = 0.f;
            for (int n = 4 * jj - 1; n <= 4 * jj + 3; ++n) if (n >= 0 && n < NCMP) imp += (pl[0][n] + pl[1][n]) + (pl[2][n] + pl[3][n]);
            const int cur = t >> 6; const bool valid = (64 * jj <= t), forced = (jj == 0) || (jj == cur) || (jj == cur - 1);
            const float score = forced ? 1e9f : (valid ? imp : -1e30f);
            int rank = 0;
            for (int jp = 0; jp < 32; ++jp) { const float sp = __shfl(score, jp, 32); rank += (sp > score || (sp == score && jp < jj)) ? 1 : 0; }
            mask = (unsigned)(__ballot(rank < 16) & 0xffffffffull);
        }
        if (j == 0 && lane == 0) SELM[m * NG + g] = mask;
        float osel;
        {
            float mm = -INFINITY, l = 0.f, o = 0.f; const int cur = t >> 6;
            for (int jb = 0; jb <= cur; ++jb) if ((mask >> jb) & 1u) {
                const int key = 64 * jb + lane;
                const float s = dot64_bf(q, zb + (size_t)key * ZQP + 768 + g * HD) * 0.125f;
                online_block(s, key <= t, zb + (size_t)(64 * jb) * ZQP + 896 + g * HD + lane, ZQP, mm, l, o);
            }
            osel = o / l;
        }
        float owin;
        {
            float mm = -INFINITY, l = 0.f, o = 0.f; const int lo = t - 511 > 0 ? t - 511 : 0;
            for (int kb = lo & ~63; kb <= t; kb += 64) {
                const int key = kb + lane;
                const float s = dot64_bf(q, zb + (size_t)key * ZQP + 1024 + g * HD) * 0.125f;
                online_block(s, key >= lo && key <= t, zb + (size_t)kb * ZQP + 1152 + g * HD + lane, ZQP, mm, l, o);
            }
            owin = o / l;
        }
        const float* gr = GATES + (size_t)m * GP;
        const float g0 = 1.f / (1.f + expf(-gr[head])), g1 = 1.f / (1.f + expf(-gr[8 + head])), g2 = 1.f / (1.f + expf(-gr[16 + head]));
        OATT[(size_t)m * DM + head * HD + lane] = f2bf(g0 * ocmp + g1 * osel + g2 * owin);
    }
}

template <int MODE> __device__ __forceinline__ void moe_naive(const Frame& F, const bf16_t* A, const bf16_t* B, bf16_t* O, const unsigned* cnt, const int* list) {
    constexpr bool DUAL = (MODE == 4);
    constexpr int K = (MODE == 4) ? DM : DFFE, NT = (MODE == 4) ? DFFE / 64 : DM / 64;
    const int hb = F.tid >> 8, tid = F.tid & 255, tx = tid & 15, ty = tid >> 4;
    float (*As)[68] = (float (*)[68])(F.ldsg + hb * 32768); float (*Bs)[68] = As + 32; float (*Bs2)[68] = Bs + 32;
    int cn[NEXP], tpre[NEXP + 1], rpre[NEXP]; { int ta = 0, ra = 0;
#pragma unroll
        for (int e = 0; e < NEXP; ++e) { cn[e] = (int)cnt[e]; tpre[e] = ta; rpre[e] = ra; ta += (cn[e] + 63) >> 6; ra += cn[e]; } tpre[NEXP] = ta; }
    const int nitems = tpre[NEXP] * NT;
    for (int base = F.vcu * 2; base < nitems; base += 2 * F.G) {
        const int item = base + hb; const bool valid = item < nitems;
        const int tile = valid ? item / NT : 0, n0 = valid ? (item % NT) * 64 : 0;
        int e = 0, rt = tile, ce = cn[0], pre = 0;
#pragma unroll
        for (int e2 = 1; e2 < NEXP; ++e2) if (tile >= tpre[e2]) { e = e2; rt = tile - tpre[e2]; ce = cn[e2]; pre = rpre[e2]; }
        const int rows_valid = min(64, ce - rt * 64), prow0 = pre + rt * 64;
        const bf16_t* Bb = B + (size_t)e * (MODE == 4 ? (size_t)2 * DFFE * DM : (size_t)DM * DFFE);
        const int lr = tid >> 2, lc = (tid & 3) * 8;
        const bf16_t* arow;
        if (MODE == 4) { const int tok = (valid && lr < rows_valid) ? list[e * MTOK + rt * 64 + lr] : 0; arow = A + (size_t)tok * K; }
        else { int p = prow0 + lr; if (p > 2 * MTOK - 1) p = 2 * MTOK - 1; arow = A + (size_t)p * K; }
        const int nl = n0 + lr;
        const bf16_t* brow = DUAL ? Bb + (size_t)((nl >> 7) * 256 + (nl & 127)) * K : Bb + (size_t)nl * K;
        const bf16_t* brow2 = DUAL ? brow + (size_t)128 * K : brow;
        float acc[4][4], acc2[4][4];
#pragma unroll
        for (int i = 0; i < 4; ++i)
#pragma unroll
            for (int jx = 0; jx < 4; ++jx) { acc[i][jx] = 0.f; acc2[i][jx] = 0.f; }
        for (int k0 = 0; k0 < K; k0 += 32) {
            const uint4 av = *(const uint4*)(arow + k0 + lc);
            const uint4 bv = *(const uint4*)(brow + k0 + lc);
            uint4 bv2 = bv; if (DUAL) bv2 = *(const uint4*)(brow2 + k0 + lc);
            __syncthreads();
            const unsigned aw[4] = {av.x, av.y, av.z, av.w}, bw[4] = {bv.x, bv.y, bv.z, bv.w}, bw2[4] = {bv2.x, bv2.y, bv2.z, bv2.w};
#pragma unroll
            for (int i = 0; i < 4; ++i) {
                As[lc + 2 * i][lr] = __uint_as_float(aw[i] << 16); As[lc + 2 * i + 1][lr] = __uint_as_float(aw[i] & 0xffff0000u);
                Bs[lc + 2 * i][lr] = __uint_as_float(bw[i] << 16); Bs[lc + 2 * i + 1][lr] = __uint_as_float(bw[i] & 0xffff0000u);
                if (DUAL) { Bs2[lc + 2 * i][lr] = __uint_as_float(bw2[i] << 16); Bs2[lc + 2 * i + 1][lr] = __uint_as_float(bw2[i] & 0xffff0000u); }
            }
            __syncthreads();
#pragma unroll 8
            for (int k = 0; k < 32; ++k) {
                const float4 a4 = *(const float4*)&As[k][ty * 4];
                const float4 b4 = *(const float4*)&Bs[k][tx * 4];
                const float af[4] = {a4.x, a4.y, a4.z, a4.w}, bf[4] = {b4.x, b4.y, b4.z, b4.w};
#pragma unroll
                for (int i = 0; i < 4; ++i)
#pragma unroll
                    for (int jx = 0; jx < 4; ++jx) acc[i][jx] += af[i] * bf[jx];
                if (DUAL) {
                    const float4 c4 = *(const float4*)&Bs2[k][tx * 4];
                    const float cf[4] = {c4.x, c4.y, c4.z, c4.w};
#pragma unroll
                    for (int i = 0; i < 4; ++i)
#pragma unroll
                        for (int jx = 0; jx < 4; ++jx) acc2[i][jx] += af[i] * cf[jx];
                }
            }
        }
        if (valid) {
#pragma unroll
            for (int i = 0; i < 4; ++i) {
                const int r = ty * 4 + i;
                if (r < rows_valid) {
                    const size_t mrow = (size_t)(prow0 + r);
#pragma unroll
                    for (int jx = 0; jx < 4; ++jx) {
                        const int n = n0 + tx * 4 + jx; const float v = acc[i][jx];
                        if (MODE == 4) { const float u = acc2[i][jx]; O[mrow * DFFE + n] = f2bf(v / (1.f + expf(-v)) * u); }
                        else O[mrow * DM + n] = f2bf(v);
                    }
                }
            }
        }
    }
}

constexpr int NPHASE = 17;
__global__ void __launch_bounds__(NTHR, 2) mega_fwd(Args args) {
    extern __shared__ __attribute__((aligned(16))) unsigned char lds[];
    Frame F;
    F.lds = (LAS unsigned char*)lds; F.ldsg = lds;
    F.MISC = (volatile LAS unsigned*)(F.lds + MISC_OFF);
    F.tid = threadIdx.x; F.lane = F.tid & 63; F.wave = __builtin_amdgcn_readfirstlane(F.tid >> 6);
    F.G = gridDim.x; { const int bx = blockIdx.x; F.vcu = (F.G % 8 == 0) ? (bx % 8) * (F.G / 8) + bx / 8 : bx; }
    for (int u = F.tid; u < (LDS_BYTES - LDSCTL_OFF) / 4; u += NTHR) ((LAS unsigned*)(F.lds + LDSCTL_OFF))[u] = 0u;
    __syncthreads();
    const int lo = args.ph_lo, hi = args.ph_hi;
    F.ctl = nullptr;
    const bool one_launch = (hi - lo) > 1;
#define KA() ({ const __attribute__((address_space(4))) Args* p_ = (const __attribute__((address_space(4))) Args*)__builtin_amdgcn_kernarg_segment_ptr(); asm volatile("" : "+s"(p_)); p_; })
#define WS(off) (KA()->ws + (off))
#define INP(i) (KA()->in[i])
    XcdBarrier bar; bar.bar = nullptr; bar.x = 0; bar.st = nullptr;
    if (one_launch) bar = xcd_barrier_post((unsigned*)WS(OFF_CTL) + CW_BAR, F.MISC + 8);
#define IN(k) ({ int lo_ = lo, hi_ = hi; asm volatile("" : "+s"(lo_), "+s"(hi_)); (lo_ <= (k) && (k) < hi_); })
#define FRESH() do { asm volatile("" : "+v"(F.tid)); F.lane = F.tid & 63; } while (0)
#define SEAM(k) do { if (IN(k) && IN((k) + 1)) { XcdBarrier b2_; b2_.bar = (unsigned*)WS(OFF_CTL) + CW_BAR; b2_.x = bar.x; b2_.st = bar.st; xcd_barrier(b2_); } } while (0)
    const int gw = F.vcu * NWAVES + F.wave, NGW = F.G * NWAVES;

    if (IN(0)) { FRESH();
        LAS float* scr = (LAS float*)(F.lds + RING_OFF + F.wave * 16384);
        bf16_t* WIN_T = (bf16_t*)WS(OFF_WIN_T);
        for (int l = 0; l < DEPTH; ++l) { uint4* p = (uint4*)(WIN_T + (size_t)l * DINP * DM + (size_t)DIN * DM); const int n16 = (DINP - DIN) * DM * 2 / 16;
            for (int i = F.vcu * NTHR + F.tid; i < n16; i += F.G * NTHR) p[i] = make_uint4(0, 0, 0, 0); }
        int it0 = gw;
#define P0_TASK(Wp, K_, N_, WTp, mode_) do { const int nit_ = ((K_) / 64) * (((N_) + 31) / 32); \
            for (; it0 < nit_; it0 += NGW) p0_transpose_item((Wp), (K_), (N_), (WTp), (mode_), scr, it0, F.lane); it0 -= nit_; } while (0)
        for (int l = 0; l < DEPTH; ++l) {
            P0_TASK(INP(3) + (size_t)l * DM * DIN, DM, DIN, (bf16_t*)WS(OFF_WIN_T) + (size_t)l * DINP * DM, 1);
            P0_TASK(INP(10) + (size_t)l * DM * DM, DM, DM, (bf16_t*)WS(OFF_WO_T) + (size_t)l * DM * DM, 0);
        }
        P0_TASK(INP(15), DM, DFF, (bf16_t*)WS(OFF_FGU_T), 2);
        P0_TASK(INP(16), DM, DFF, (bf16_t*)WS(OFF_FGU_T), 3);
        P0_TASK(INP(17), DFF, DM, (bf16_t*)WS(OFF_FD_T), 0);
        for (int e = 0; e < NEXP; ++e) {
            P0_TASK(INP(19) + (size_t)e * DM * DFFE, DM, DFFE, (bf16_t*)WS(OFF_MGU_T) + (size_t)e * 2 * DFFE * DM, 2);
            P0_TASK(INP(20) + (size_t)e * DM * DFFE, DM, DFFE, (bf16_t*)WS(OFF_MGU_T) + (size_t)e * 2 * DFFE * DM, 3);
            P0_TASK(INP(21) + (size_t)e * DFFE * DM, DFFE, DM, (bf16_t*)WS(OFF_MD_T) + (size_t)e * DM * DFFE, 0);
        }
#undef P0_TASK
        LnP a{}; a.X = INP(0); a.g = INP(1); a.b = INP(2); a.HF = KA()->out; a.HB = (bf16_t*)WS(OFF_HB);
        for (int m = gw; m < MTOK; m += NGW) { float4 o[4]; ln_row<0>(a, m, F.lane, o); }
    }
    SEAM(0);
    for (int l = 0; l < DEPTH; ++l) {
        const int pb = 1 + 8 * l;
        if (IN(pb + 0)) { FRESH();
            pg8::APlain ap{(const char*)WS(OFF_HB), (unsigned)DM * 2u}; pg8::StaticOrder S; S.init(MTOK / 256, DINP / 256, F.G, (int)blockIdx.x);
            pg8::EpiWin E{(bf16_t*)WS(OFF_ZQ), (bf16_t*)WS(OFF_ZC), (float*)WS(OFF_GATES)};
            pg8::gemm_phase<pg8::EpiWin, pg8::APlain, pg8::StaticOrder, true>(F.lds + RING_OFF, ap, (const bf16_t*)WS(OFF_WIN_T) + (size_t)l * DINP * DM, DM, S, E, F.tid);
        }
        SEAM(pb + 0);
        if (IN(pb + 1)) { FRESH();
            compress_items(F, (const bf16_t*)WS(OFF_ZQ), INP(4) + (size_t)l * 2 * 2048, INP(5) + (size_t)l * 2 * 2048 * CMPH, INP(6) + (size_t)l * 2 * CMPH, INP(7) + (size_t)l * 2 * CMPH * HD, INP(8) + (size_t)l * 2 * HD, (float*)WS(OFF_KC));
            conv_items(F, (const bf16_t*)WS(OFF_ZC), INP(9) + (size_t)l * 3 * 512, (bf16_t*)WS(OFF_OATT));
        }
        SEAM(pb + 1);
        if (IN(pb + 2)) { FRESH(); __syncthreads(); attn_items(F, (const bf16_t*)WS(OFF_ZQ), (const float*)WS(OFF_GATES), (const float*)WS(OFF_KC), (const float*)WS(OFF_KC) + (size_t)BATCH * NG * 128 * HD, (bf16_t*)WS(OFF_OATT), (unsigned*)WS(OFF_SELM)); }
        SEAM(pb + 2);
        if (IN(pb + 3)) { FRESH();
            __syncthreads();
            pg8::APlain ap{(const char*)WS(OFF_OATT), (unsigned)DM * 2u}; pg8::StaticOrder S; S.init(MTOK / 256, DM / 256, F.G, (int)blockIdx.x);
            pg8::EpiF32 E{(float*)WS(OFF_ZQ), DM};
            pg8::gemm_phase<pg8::EpiF32, pg8::APlain, pg8::StaticOrder, true>(F.lds + RING_OFF, ap, (const bf16_t*)WS(OFF_WO_T) + (size_t)l * DM * DM, DM, S, E, F.tid);
        }
        SEAM(pb + 3);
        if (IN(pb + 4)) { FRESH();
            LnP a{}; a.TMP = (const float*)WS(OFF_ZQ); a.g = INP(11) + l * DM; a.b = INP(12) + l * DM; a.HF = KA()->out; a.HB = (bf16_t*)WS(OFF_HB);
            const float* Wr = INP(18); unsigned* cnt = (unsigned*)WS(OFF_CTL) + CW_CNT; int* TOPE = (int*)WS(OFF_TOPE); float* TOPW = (float*)WS(OFF_TOPW); int* LIST = (int*)WS(OFF_LIST);
            for (int m = gw; m < MTOK; m += NGW) { float4 o[4]; ln_row<1>(a, m, F.lane, o); if (l & 1) route_row(o, m, F.lane, Wr, cnt, TOPE, TOPW, LIST); }
        }
        SEAM(pb + 4);
        if ((l & 1) == 0) {
            if (IN(pb + 5)) { FRESH();
                pg8::APlain ap{(const char*)WS(OFF_HB), (unsigned)DM * 2u}; pg8::StaticOrder S; S.init(MTOK / 256, 2 * DFF / 256, F.G, (int)blockIdx.x);
                pg8::EpiSwiglu E{(bf16_t*)WS(OFF_ZQ), DFF};
                pg8::gemm_phase<pg8::EpiSwiglu, pg8::APlain, pg8::StaticOrder, true>(F.lds + RING_OFF, ap, (const bf16_t*)WS(OFF_FGU_T), DM, S, E, F.tid);
            }
            SEAM(pb + 5);
            if (IN(pb + 6)) { FRESH();
                pg8::APlain ap{(const char*)WS(OFF_ZQ), (unsigned)DFF * 2u}; pg8::StaticOrder S; S.init(MTOK / 256, DM / 256, F.G, (int)blockIdx.x);
                pg8::EpiBf16 E{(bf16_t*)WS(OFF_OATT), DM};
                pg8::gemm_phase<pg8::EpiBf16, pg8::APlain, pg8::StaticOrder, true>(F.lds + RING_OFF, ap, (const bf16_t*)WS(OFF_FD_T), DFF, S, E, F.tid);
            }
            SEAM(pb + 6);
            if (IN(pb + 7)) { FRESH();
                LnP a{}; a.TMPB = (const bf16_t*)WS(OFF_OATT); a.g = INP(13) + l * DM; a.b = INP(14) + l * DM; a.HF = KA()->out; a.HB = (bf16_t*)WS(OFF_HB);
                for (int m = gw; m < MTOK; m += NGW) { float4 o[4]; ln_row<3>(a, m, F.lane, o); }
            }
            SEAM(pb + 7);
        } else {
            if (IN(pb + 5)) { FRESH(); __syncthreads(); moe_naive<4>(F, (const bf16_t*)WS(OFF_HB), (const bf16_t*)WS(OFF_MGU_T), (bf16_t*)WS(OFF_ZQ), (const unsigned*)WS(OFF_CTL) + CW_CNT, (const int*)WS(OFF_LIST)); }
            SEAM(pb + 5);
            if (IN(pb + 6)) { FRESH(); __syncthreads(); moe_naive<5>(F, (const bf16_t*)WS(OFF_ZQ), (const bf16_t*)WS(OFF_MD_T), (bf16_t*)WS(OFF_HB), (const unsigned*)WS(OFF_CTL) + CW_CNT, (const int*)WS(OFF_LIST)); }
            SEAM(pb + 6);
            if (IN(pb + 7)) { FRESH();
                LnP a{}; a.PO = (const bf16_t*)WS(OFF_HB); a.tope = (const int*)WS(OFF_TOPE); a.topw = (const float*)WS(OFF_TOPW); a.cnt = (const unsigned*)WS(OFF_CTL) + CW_CNT; a.g = INP(13) + l * DM; a.b = INP(14) + l * DM; a.HF = KA()->out; a.HB = (bf16_t*)WS(OFF_HB);
                for (int m = gw; m < MTOK; m += NGW) { float4 o[4]; ln_row<2>(a, m, F.lane, o); }
            }
            SEAM(pb + 7);
        }
    }
#undef IN
#undef FRESH
#undef SEAM
#undef KA
#undef WS
#undef INP
}

#ifndef MK_N_LAUNCHES
#define MK_N_LAUNCHES 1
#endif
extern "C" void kernel_launch(void* const* d_in, const int* in_sizes, int n_in, void* d_out, int out_size, void* d_ws, size_t ws_size, hipStream_t stream) {
    (void)in_sizes; (void)out_size; (void)ws_size;
    static int grid = 0;
    if (grid == 0) {
        int dev = 0, cus = 0, per_cu = 0;
        if (n_in != 22 || hipGetDevice(&dev) != hipSuccess || hipDeviceGetAttribute(&cus, hipDeviceAttributeMultiprocessorCount, dev) != hipSuccess) { grid = -1; return; }
        if (hipFuncSetAttribute((const void*)mega_fwd, hipFuncAttributeMaxDynamicSharedMemorySize, LDS_BYTES) != hipSuccess) { grid = -1; return; }
        if (hipOccupancyMaxActiveBlocksPerMultiprocessor(&per_cu, (const void*)mega_fwd, NTHR, LDS_BYTES) != hipSuccess || per_cu < 1) { grid = -1; return; }
        (void)hipGetLastError();
        grid = cus;
    }
    if (grid < 0) return;
    (void)hipMemsetAsync((char*)d_ws + OFF_CTL, 0, CTL_ZERO_BYTES, stream);
    Args a{};
    for (int i = 0; i < 22; ++i) a.in[i] = (const float*)d_in[i];
    a.out = (float*)d_out; a.ws = (unsigned char*)d_ws;
    if (MK_N_LAUNCHES == 1) {
        a.ph_lo = 0; a.ph_hi = NPHASE;
        void* kargs[] = {&a};
        (void)hipLaunchCooperativeKernel((const void*)mega_fwd, dim3(grid), dim3(NTHR), kargs, LDS_BYTES, stream);
    } else {
        for (int p = 0; p < NPHASE; ++p) { a.ph_lo = p; a.ph_hi = p + 1; hipLaunchKernelGGL(mega_fwd, dim3(grid), dim3(NTHR), LDS_BYTES, stream, a); }
    }
}
```

```cpp
#include <hip/hip_runtime.h>
#include <stdint.h>
#include <math.h>

typedef unsigned short bf16_t;
#define LAS __attribute__((address_space(3)))
#define GAS __attribute__((address_space(1)))

constexpr int DM = 1024, BATCH = 8, SEQ = 2048, DEPTH = 2;
constexpr int MTOK = BATCH * SEQ;
constexpr int NH = 8, NG = 2, HPG = 4, HD = 64;
constexpr int DIN = 2840, DINP = 3072;
constexpr int NCMP = 127, CMPH = 256;
constexpr int DFF = 2816, NEXP = 8, DFFE = 1408;
constexpr int ZQP = 1280;
constexpr int ZCP = 1536;
constexpr int GP = 32;
constexpr float ALPHA = 1.41421356237309515f;
constexpr float LN_EPS = 1e-5f;
constexpr int NWAVES = 8, NTHR = 512;

constexpr size_t OFF_CTL = 0;
constexpr size_t SZ_WIN_T = (size_t)DINP * DM * 2;
constexpr size_t OFF_WIN_T = 1u << 20;
constexpr size_t OFF_CW1_T = OFF_WIN_T + 2 * SZ_WIN_T;
constexpr size_t OFF_WO_T = OFF_CW1_T + 4 * 1048576;
constexpr size_t OFF_FGU_T = OFF_WO_T + 2 * 2097152;
constexpr size_t OFF_FD_T = OFF_FGU_T + (size_t)2 * DFF * DM * 2;
constexpr size_t OFF_MGU_T = OFF_FD_T + (size_t)DM * DFF * 2;
constexpr size_t OFF_MD_T = OFF_MGU_T + (size_t)NEXP * 2 * DFFE * DM * 2;
constexpr size_t OFF_HB = OFF_MD_T + (size_t)NEXP * DM * DFFE * 2;
constexpr size_t OFF_OATT = OFF_HB + (size_t)MTOK * DM * 2;
constexpr size_t OFF_ZQ = OFF_OATT + (size_t)MTOK * DM * 2;
constexpr size_t OFF_ZC = OFF_ZQ + (size_t)MTOK * ZQP * 2;
constexpr size_t OFF_GATES = OFF_ZC + (size_t)MTOK * ZCP * 2;
constexpr size_t OFF_KC = OFF_GATES + (size_t)MTOK * GP * 4;
constexpr size_t OFF_SELM = OFF_KC + 1048576;
constexpr size_t OFF_TOPE = OFF_SELM + 131072;
constexpr size_t OFF_TOPW = OFF_TOPE + 131072;
constexpr size_t OFF_LIST = OFF_TOPW + 131072;
constexpr size_t OFF_XCH = OFF_LIST + 524288;
constexpr size_t WS_END = OFF_XCH + 4 * 524288;
static_assert(WS_END <= 280552448ull, "d_ws map exceeds the guaranteed workspace");
static_assert((size_t)MTOK * DFF * 2 == (size_t)MTOK * (ZQP + ZCP) * 2, "ACT overlays ZQ+ZC exactly");
constexpr int CW_TMO = 0, CW_CODE = 1;
constexpr int CW_CNT = 512;
constexpr int CW_BAR = 4096;
constexpr int CW_SEAM = 16384, SEAM_BANK = 128 * 64;
constexpr size_t CTL_ZERO_BYTES = 1u << 20;
static_assert((CW_SEAM + 4 * SEAM_BANK) * 4 <= (int)CTL_ZERO_BYTES, "CTL words inside the memset region");

constexpr int RING_OFF = 0, RING_BYTES = 131072;
constexpr int LDSCTL_OFF = RING_BYTES, MISC_OFF = LDSCTL_OFF + 320;
constexpr int LDS_BYTES = 147456;

__device__ __forceinline__ float bf2f(bf16_t v) { return __uint_as_float((unsigned)v << 16); }
__device__ __forceinline__ bf16_t f2bf(float f) { unsigned u = __float_as_uint(f); return (bf16_t)((u + 0x7fffu + ((u >> 16) & 1u)) >> 16); }
__device__ __forceinline__ unsigned pk2(float lo, float hi) { return (unsigned)f2bf(lo) | ((unsigned)f2bf(hi) << 16); }
__device__ __forceinline__ float wave_sum(float v) {
#pragma unroll
    for (int o = 32; o > 0; o >>= 1) v += __shfl_xor(v, o);
    return v;
}
__device__ __forceinline__ float wave_max(float v) {
#pragma unroll
    for (int o = 32; o > 0; o >>= 1) v = fmaxf(v, __shfl_xor(v, o));
    return v;
}
namespace pg8 {
#define PG8_LAS __attribute__((address_space(3)))
typedef short bf16x8 __attribute__((ext_vector_type(8)));
typedef float f32x4 __attribute__((ext_vector_type(4)));
typedef float f32x2 __attribute__((ext_vector_type(2)));
typedef unsigned u32x4 __attribute__((ext_vector_type(4)));
typedef unsigned u32x2 __attribute__((ext_vector_type(2)));
constexpr int BM = 256, BK = 64, HALF = 128, HTB = HALF * BK * 2  , STAGE_BYTES = 8 * HTB, NXCD = 8, WGM = 8;

__host__ __device__ __forceinline__ int lds_byte(int r, int c) { const int st = (r >> 4) * 2 + (c >> 5), rr = r & 15, cc = c & 31, ob = rr * 64 + cc * 2; return st * 1024 + (ob ^ (((ob >> 9) & 1) << 5)); }
__host__ __device__ __forceinline__ void stage_rc(int b, int& R, int& C) { const int st = b / 1024, sb = b % 1024, swz = sb ^ (((sb >> 9) & 1) << 5); R = (st >> 1) * 16 + swz / 64; C = (st & 1) * 32 + (swz % 64) / 2; }
__host__ __device__ __forceinline__ int perm32(int rho) { const int n = rho >> 4, i = rho & 15; return 8 * (i >> 2) + 4 * n + (i & 3); }

struct Unit { int pm, pn; };

struct StaticOrder {
    int nM, nN, nwg, G, c;
    __host__ __device__ void init(int nM_, int nN_, int G_, int c_) { nM = nM_; nN = nN_; nwg = nM * nN; G = G_; c = c_; }
    __host__ __device__ bool next(int i, Unit& u) const {
        const long L = (long)i * G + c; if (L >= nwg) return false;
        int wgid = (int)L; { const int q = nwg / NXCD, r = nwg % NXCD, xcd = wgid % NXCD, off = wgid / NXCD; wgid = (xcd < r ? xcd * (q + 1) : r * (q + 1) + (xcd - r) * q) + off; }
        const int nig = WGM * nN, gid = wgid / nig, fm = gid * WGM, gsz = (nM - fm) < WGM ? (nM - fm) : WGM;
        u.pm = fm + ((wgid % nig) % gsz); u.pn = (wgid % nig) / gsz; return true;
    }
};

struct APlain {
    const char* A; unsigned row_bytes;
    __device__ __forceinline__ const char* base(int pm, int h) const { return A + (size_t)(pm * BM + h * HALF) * row_bytes; }
    __device__ __forceinline__ size_t kstep() const { return (size_t)BK * 2; }
    __device__ __forceinline__ unsigned voff(int R, int C) const { return (unsigned)R * row_bytes + (unsigned)C * 2u; }
};

__device__ __forceinline__ unsigned cvt_pk_bf16(float lo, float hi) { unsigned r; asm volatile("v_cvt_pk_bf16_f32 %0, %1, %2" : "=v"(r) : "v"(lo), "v"(hi)); return r; }

struct EpiF32 {
    static constexpr bool PERM = false, AFTER_DRAIN = false;
    float* C; int ldc;
    __device__ __forceinline__ void operator()(const f32x4 (&acc)[2][2][4][2], const Unit& u, int wr, int wc, int fr, int fq) const {
        const int row0 = u.pm * BM + wr * 64 + fr, col0 = u.pn * BM + wc * 32 + 4 * fq;
#pragma unroll
        for (int ai = 0; ai < 2; ++ai)
#pragma unroll
            for (int m = 0; m < 4; ++m) { float* rowp = C + (size_t)(row0 + ai * HALF + m * 16) * ldc + col0;
#pragma unroll
                for (int bj = 0; bj < 2; ++bj)
#pragma unroll
                    for (int n = 0; n < 2; ++n) *(f32x4*)(rowp + bj * HALF + n * 16) = acc[ai][bj][m][n]; }
    }
};
struct EpiBf16 {
    static constexpr bool PERM = true, AFTER_DRAIN = false;
    bf16_t* O; int ldc;
    __device__ __forceinline__ void operator()(const f32x4 (&acc)[2][2][4][2], const Unit& u, int wr, int wc, int fr, int fq) const {
        const int row0 = u.pm * BM + wr * 64 + fr, col0 = u.pn * BM + wc * 32 + 8 * fq;
#pragma unroll
        for (int ai = 0; ai < 2; ++ai)
#pragma unroll
            for (int m = 0; m < 4; ++m) { bf16_t* rowp = O + (size_t)(row0 + ai * HALF + m * 16) * ldc + col0;
#pragma unroll
                for (int bj = 0; bj < 2; ++bj) { const f32x4 v0 = acc[ai][bj][m][0], v1 = acc[ai][bj][m][1];
                    u32x4 w; w.x = cvt_pk_bf16(v0[0], v0[1]); w.y = cvt_pk_bf16(v0[2], v0[3]); w.z = cvt_pk_bf16(v1[0], v1[1]); w.w = cvt_pk_bf16(v1[2], v1[3]);
                    *(u32x4*)(rowp + bj * HALF) = w; } }
    }
};
struct EpiWin {
    static constexpr bool PERM = true, AFTER_DRAIN = false;
    bf16_t* ZQ; bf16_t* ZC; float* GATES;
    __device__ __forceinline__ void operator()(const f32x4 (&acc)[2][2][4][2], const Unit& u, int wr, int wc, int fr, int fq) const {
        const int row0 = u.pm * BM + wr * 64 + fr;
        if (u.pn < 11) {
            bf16_t* base; int pitch, colt;
            if (u.pn < 5) { base = ZQ; pitch = ZQP; colt = u.pn * BM; } else { base = ZC; pitch = ZCP; colt = (u.pn - 5) * BM; }
            const int col0 = colt + wc * 32 + 8 * fq;
            const float sc = (u.pn < 2) ? 0.125f * 1.4426950408889634f : 1.0f;
#pragma unroll
            for (int ai = 0; ai < 2; ++ai)
#pragma unroll
                for (int m = 0; m < 4; ++m) { bf16_t* rowp = base + (size_t)(row0 + ai * HALF + m * 16) * pitch + col0;
#pragma unroll
                    for (int bj = 0; bj < 2; ++bj) { const f32x4 v0 = acc[ai][bj][m][0] * sc, v1 = acc[ai][bj][m][1] * sc;
                        u32x4 w; w.x = cvt_pk_bf16(v0[0], v0[1]); w.y = cvt_pk_bf16(v0[2], v0[3]); w.z = cvt_pk_bf16(v1[0], v1[1]); w.w = cvt_pk_bf16(v1[2], v1[3]);
                        *(u32x4*)(rowp + bj * HALF) = w; } }
        } else if (wc == 0 && fq < 3) {
#pragma unroll
            for (int ai = 0; ai < 2; ++ai)
#pragma unroll
                for (int m = 0; m < 4; ++m) { float* gp = GATES + (size_t)(row0 + ai * HALF + m * 16) * GP + 8 * fq;
                    *(f32x4*)(gp) = acc[ai][0][m][0]; *(f32x4*)(gp + 4) = acc[ai][0][m][1]; }
        }
    }
};
__device__ __forceinline__ float silu_mul(float g, float u) { return g * __builtin_amdgcn_rcpf(1.0f + __builtin_amdgcn_exp2f(-1.4426950408889634f * g)) * u; }
struct EpiSwiglu {
    static constexpr bool PERM = true, AFTER_DRAIN = false;
    bf16_t* O; int ldc;
    __device__ __forceinline__ void operator()(const f32x4 (&acc)[2][2][4][2], const Unit& u, int wr, int wc, int fr, int fq) const {
        const int row0 = u.pm * BM + wr * 64 + fr, col0 = u.pn * HALF + wc * 32 + 8 * fq;
#pragma unroll
        for (int ai = 0; ai < 2; ++ai)
#pragma unroll
            for (int m = 0; m < 4; ++m) { bf16_t* rowp = O + (size_t)(row0 + ai * HALF + m * 16) * ldc + col0;
                const f32x4 g0 = acc[ai][0][m][0], g1 = acc[ai][0][m][1], u0 = acc[ai][1][m][0], u1 = acc[ai][1][m][1];
                u32x4 w; w.x = cvt_pk_bf16(silu_mul(g0[0], u0[0]), silu_mul(g0[1], u0[1])); w.y = cvt_pk_bf16(silu_mul(g0[2], u0[2]), silu_mul(g0[3], u0[3]));
                w.z = cvt_pk_bf16(silu_mul(g1[0], u1[0]), silu_mul(g1[1], u1[1])); w.w = cvt_pk_bf16(silu_mul(g1[2], u1[2]), silu_mul(g1[3], u1[3]));
                *(u32x4*)rowp = w; }
    }
};

template <class Epi, class AP, class Sched, bool ALIGN_EPI>
__device__ __forceinline__ void gemm_phase(PG8_LAS unsigned char* lds, const AP ap, const bf16_t* Bt, const int K, const Sched& S, const Epi& E, const int tid) {
    const int wid = __builtin_amdgcn_readfirstlane(tid >> 6), lane = tid & 63, wr = wid >> 2, wc = wid & 3, fr = lane & 15, fq = lane >> 4;
    const int nt = K / BK;
    unsigned voffA[2], voffB[2];
#pragma unroll
    for (int i = 0; i < 2; ++i) { int R, C; stage_rc(tid * 16 + i * 8192, R, C); const int Rb = Epi::PERM ? ((R & ~31) + perm32(R & 31)) : R;
        voffA[i] = ap.voff(R, C); voffB[i] = (unsigned)(Rb * K + C) * 2u; }
    const size_t kstepA = ap.kstep();
    const size_t kstepB = (size_t)(BK * 2);
    const size_t hstepB = (size_t)HALF * K * 2;
    const size_t tstepB = 2 * hstepB;
    const unsigned ldsw = (unsigned)wid * 1024u;
    const int aoff = lds_byte(wr * 64 + fr, fq * 8), boff = lds_byte(wc * 32 + fr, fq * 8);
#define PG8_SA(b, h) (((b) * 2 + (h)) * HTB)
#define PG8_SB(b, h) ((4 + (b) * 2 + (h)) * HTB)
#define PG8_STAGE(bufoff, gbase, voff) do { _Pragma("unroll") for (int _i = 0; _i < 2; ++_i) \
        __builtin_amdgcn_global_load_lds((const unsigned*)((const char*)(gbase) + (voff)[_i]), (PG8_LAS unsigned*)(lds + (bufoff) + ldsw + _i * 8192), 16, 0, 0); } while (0)
#define PG8_LDA(dst, b, h) do { _Pragma("unroll") for (int m = 0; m < 4; ++m) _Pragma("unroll") for (int k = 0; k < 2; ++k) dst[m][k] = *(const PG8_LAS bf16x8*)(lds + PG8_SA(b, h) + aoff + m * 2048 + k * 1024); } while (0)
#define PG8_LDB(dst, b, h) do { _Pragma("unroll") for (int n = 0; n < 2; ++n) _Pragma("unroll") for (int k = 0; k < 2; ++k) dst[n][k] = *(const PG8_LAS bf16x8*)(lds + PG8_SB(b, h) + boff + n * 2048 + k * 1024); } while (0)
#define PG8_MMA(ai, bj, At, Bt_) do { __builtin_amdgcn_s_setprio(1); _Pragma("unroll") for (int m = 0; m < 4; ++m) _Pragma("unroll") for (int n = 0; n < 2; ++n) _Pragma("unroll") for (int k = 0; k < 2; ++k) \
        acc[ai][bj][m][n] = __builtin_amdgcn_mfma_f32_16x16x32_bf16(Bt_[n][k], At[m][k], acc[ai][bj][m][n], 0, 0, 0); __builtin_amdgcn_s_setprio(0); } while (0)
#define PG8_WAIT_V(n) asm volatile("s_waitcnt vmcnt(" #n ")" ::: "memory")
#define PG8_WAIT_L(n) asm volatile("s_waitcnt lgkmcnt(" #n ")" ::: "memory")
#define PG8_BAR __builtin_amdgcn_s_barrier()
#define PG8_SCHED __builtin_amdgcn_sched_barrier(0)
    Unit cur, nxt; int ui = 0;
    if (!S.next(0, cur)) return;
    f32x4 acc[2][2][4][2];
#pragma unroll
    for (int a = 0; a < 2; ++a)
#pragma unroll
        for (int b = 0; b < 2; ++b)
#pragma unroll
            for (int m = 0; m < 4; ++m)
#pragma unroll
                for (int n = 0; n < 2; ++n) acc[a][b][m][n] = (f32x4){0.f, 0.f, 0.f, 0.f};
    bf16x8 At[4][2], B0[2][2], B1[2][2];
    const char* cA0 = ap.base(cur.pm, 0); const char* cA1 = ap.base(cur.pm, 1); const char* cB = (const char*)Bt + (size_t)cur.pn * tstepB;
    PG8_STAGE(PG8_SB(0, 0), cB, voffB); PG8_STAGE(PG8_SB(0, 1), cB + hstepB, voffB); PG8_STAGE(PG8_SA(0, 0), cA0, voffA); PG8_STAGE(PG8_SA(0, 1), cA1, voffA);
    if (wr == 1) PG8_BAR;
    PG8_WAIT_V(2); PG8_BAR;
    PG8_STAGE(PG8_SB(1, 0), cB + kstepB, voffB); PG8_STAGE(PG8_SA(1, 0), cA0 + kstepA, voffA); PG8_STAGE(PG8_SB(1, 1), cB + hstepB + kstepB, voffB);
    PG8_WAIT_V(6); PG8_BAR;
    for (;;) {
        const bool has_next = S.next(ui + 1, nxt);
        const char* nA0 = has_next ? ap.base(nxt.pm, 0) : cA0; const char* nA1 = has_next ? ap.base(nxt.pm, 1) : cA1;
        const char* nB = has_next ? (const char*)Bt + (size_t)nxt.pn * tstepB : cB;
        for (int t = 0; t < nt; t += 2) {
            const bool last = (t == nt - 2);
            const char* a1_1 = cA1 + (size_t)(t + 1) * kstepA;
            const char* a2_0 = last ? nA0 : cA0 + (size_t)(t + 2) * kstepA; const char* a2_1 = last ? nA1 : cA1 + (size_t)(t + 2) * kstepA;
            const char* b2 = last ? nB : cB + (size_t)(t + 2) * kstepB;
            const char* a3_0 = a2_0 + kstepA; const char* b3 = b2 + kstepB;
            PG8_LDB(B0, 0, 0); PG8_LDB(B1, 0, 1); PG8_SCHED; PG8_LDA(At, 0, 0); PG8_STAGE(PG8_SA(1, 1), a1_1, voffA);
            PG8_WAIT_V(8); PG8_WAIT_L(0); PG8_BAR; PG8_MMA(0, 0, At, B0); PG8_MMA(0, 1, At, B1); PG8_BAR; PG8_SCHED;
            PG8_LDA(At, 0, 1); PG8_STAGE(PG8_SB(0, 0), b2, voffB); PG8_STAGE(PG8_SB(0, 1), b2 + hstepB, voffB); PG8_STAGE(PG8_SA(0, 0), a2_0, voffA);
            PG8_WAIT_V(8); PG8_WAIT_L(0); PG8_BAR; PG8_MMA(1, 0, At, B0); PG8_MMA(1, 1, At, B1); PG8_BAR; PG8_SCHED;
            PG8_LDB(B0, 1, 0); PG8_LDB(B1, 1, 1); PG8_SCHED; PG8_LDA(At, 1, 0); PG8_STAGE(PG8_SA(0, 1), a2_1, voffA);
            PG8_WAIT_V(8); PG8_WAIT_L(0); PG8_BAR; PG8_MMA(0, 0, At, B0); PG8_MMA(0, 1, At, B1); PG8_BAR; PG8_SCHED;
            PG8_LDA(At, 1, 1); PG8_STAGE(PG8_SB(1, 0), b3, voffB); PG8_STAGE(PG8_SB(1, 1), b3 + hstepB, voffB); PG8_STAGE(PG8_SA(1, 0), a3_0, voffA);
            PG8_WAIT_V(8); PG8_WAIT_L(0); PG8_BAR; PG8_MMA(1, 0, At, B0); PG8_MMA(1, 1, At, B1); PG8_BAR; PG8_SCHED;
        }
        if constexpr (ALIGN_EPI) { if (wr == 0) PG8_BAR; }
        if constexpr (!Epi::AFTER_DRAIN) { E(acc, cur, wr, wc, fr, fq); }
        if (!has_next) break;
#pragma unroll
        for (int a = 0; a < 2; ++a)
#pragma unroll
            for (int b = 0; b < 2; ++b)
#pragma unroll
                for (int m = 0; m < 4; ++m)
#pragma unroll
                    for (int n = 0; n < 2; ++n) acc[a][b][m][n] = (f32x4){0.f, 0.f, 0.f, 0.f};
        cur = nxt; cA0 = nA0; cA1 = nA1; cB = nB; ++ui;
        if constexpr (ALIGN_EPI) { if (wr == 1) PG8_BAR; }
    }
    PG8_WAIT_V(0);
    if constexpr (!ALIGN_EPI) { if (wr == 0) PG8_BAR; }
    PG8_BAR;
    if constexpr (Epi::AFTER_DRAIN) { E.fused(acc, cur, wr, wc, fr, fq, lds, wid, lane); }
#undef PG8_SA
#undef PG8_SB
#undef PG8_STAGE
#undef PG8_LDA
#undef PG8_LDB
#undef PG8_MMA
#undef PG8_WAIT_V
#undef PG8_WAIT_L
#undef PG8_BAR
#undef PG8_SCHED
}
}
#define XB_TMO      128
#define XB_XCNT(j)  (256  + 64 * (j))
#define XB_XSUB(j)  (1280 + 64 * (j))
#define XB_XGEN(j)  (2304 + 64 * (j))
#define XB_TOP      3328
#define XB_TOPGEN   3392
#define XCD_BAR_WORDS 3456
#define XB_SPIN_CAP (1u << 18)

__device__ __forceinline__ unsigned xb_ld(unsigned* p)              { return __hip_atomic_load(p, __ATOMIC_RELAXED, __HIP_MEMORY_SCOPE_AGENT); }
__device__ __forceinline__ unsigned xb_add(unsigned* p, unsigned v) { return __hip_atomic_fetch_add(p, v, __ATOMIC_RELAXED, __HIP_MEMORY_SCOPE_AGENT); }
__device__ __forceinline__ unsigned xb_xcc_id() { return (unsigned)__builtin_amdgcn_s_getreg((3 << 11) | 20) & 0xFu; }
#define XB_SPIN(cond, bar) do { unsigned _sp = 0; while (cond) { __builtin_amdgcn_s_sleep(1); \
    if ((++_sp & 255u) == 0u) { if (xb_ld(&(bar)[XB_TMO])) break; if (_sp > XB_SPIN_CAP) { atomicAdd(&(bar)[XB_TMO], 1u); break; } } } } while (0)

struct XcdBarrier {
    unsigned* bar; unsigned x;
    volatile LAS unsigned* st;
};

__device__ __forceinline__ XcdBarrier xcd_barrier_post(unsigned* bar, volatile LAS unsigned* st) {
    XcdBarrier b; b.bar = bar; b.x = xb_xcc_id(); b.st = st;
    if (threadIdx.x == 0) (void)xb_add(&bar[XB_XCNT(b.x)], 1u);
    return b;
}
__device__ __forceinline__ void xcd_barrier_complete(unsigned* bar, unsigned x, unsigned& nloc, unsigned& nx) {
    const unsigned G = gridDim.x * gridDim.y * gridDim.z;
    unsigned sum, cnt, mine, sp = 0u;
    for (;;) {
        sum = 0u; cnt = 0u; mine = 0u;
#pragma unroll
        for (unsigned j = 0; j < 16; ++j) { const unsigned c = xb_ld(&bar[XB_XCNT(j)]); sum += c; cnt += (c > 0u) ? 1u : 0u; mine = (j == x) ? c : mine; }
        if (sum == G) break;
        __builtin_amdgcn_s_sleep(1);
        if ((++sp & 255u) == 0u) { if (xb_ld(&bar[XB_TMO])) break; if (sp > XB_SPIN_CAP) { atomicAdd(&bar[XB_TMO], 1u); break; } }
    }
    nloc = mine > 0u ? mine : 1u; nx = cnt > 0u ? cnt : 1u;
}

__device__ __forceinline__ void xcd_barrier(const XcdBarrier& b) {
    asm volatile("s_waitcnt vmcnt(0)" ::: "memory");
    __syncthreads();
    if (threadIdx.x == 0) {
        unsigned* bar = b.bar;
        __builtin_amdgcn_s_waitcnt(0);
        unsigned nloc = b.st[0], nx = b.st[1];
        if (nloc == 0u) { xcd_barrier_complete(bar, b.x, nloc, nx); b.st[0] = nloc; b.st[1] = nx; }
        const unsigned old = xb_add(&bar[XB_XSUB(b.x)], 1u);
        const unsigned gen = old / nloc;
        if (old + 1u == (gen + 1u) * nloc) {
            __builtin_amdgcn_fence(__ATOMIC_RELEASE, "agent");
            asm volatile("s_waitcnt vmcnt(0)" ::: "memory");
            const unsigned og = xb_add(&bar[XB_TOP], 1u);
            const unsigned tg = og / nx;
            if (og + 1u == (tg + 1u) * nx) xb_add(&bar[XB_TOPGEN], 1u);
            else XB_SPIN(xb_ld(&bar[XB_TOPGEN]) == tg, bar);
            __builtin_amdgcn_fence(__ATOMIC_ACQUIRE, "agent");
            xb_add(&bar[XB_XGEN(b.x)], 1u);
            asm volatile("s_waitcnt vmcnt(0)" ::: "memory");
        } else {
            XB_SPIN(xb_ld(&bar[XB_XGEN(b.x)]) == gen, bar);
            __builtin_amdgcn_fence(__ATOMIC_ACQUIRE, "agent");
            asm volatile("s_waitcnt vmcnt(0)" ::: "memory");
        }
    }
    __syncthreads();
}

struct Args { const float* in[22]; float* out; unsigned char* ws; int ph_lo, ph_hi; };
struct Frame {
    LAS unsigned char* lds; unsigned char* ldsg;
    volatile LAS unsigned* MISC;
    unsigned* ctl;
    int tid, lane, wave, vcu, G;
};
#define LDS_WAIT() asm volatile("s_waitcnt lgkmcnt(0)" ::: "memory")


namespace att {
typedef short bf16x8 __attribute__((ext_vector_type(8)));
typedef short s16x4 __attribute__((ext_vector_type(4)));
typedef short v4i16_t __attribute__((ext_vector_type(4)));
typedef float f32x16 __attribute__((ext_vector_type(16)));
typedef unsigned u32x4 __attribute__((ext_vector_type(4)));
constexpr float C2 = 0.125f * 1.4426950408889634f;
constexpr float NEG = -1.0e30f;
constexpr int L_KV = 0;
constexpr int L_IMP = 32768;
constexpr int L_WSF = L_IMP + 34816;
constexpr int L_SELM = L_WSF + 2048;
constexpr int L_END = L_SELM + 512;
__device__ __forceinline__ int crow(int r, int hi) { return (r & 3) + 8 * (r >> 2) + 4 * hi; }
__device__ __forceinline__ unsigned cvtpk(float lo, float hi) { typedef float f2 __attribute__((ext_vector_type(2))); typedef __bf16 b2 __attribute__((ext_vector_type(2))); f2 v = {lo, hi}; b2 b = __builtin_convertvector(v, b2); return __builtin_bit_cast(unsigned, b); }
__device__ __forceinline__ float pmax(float v) { auto rr = __builtin_amdgcn_permlane32_swap(__float_as_uint(v), __float_as_uint(v), false, false); return fmaxf(__uint_as_float(rr[0]), __uint_as_float(rr[1])); }
__device__ __forceinline__ float psum(float v) { auto rr = __builtin_amdgcn_permlane32_swap(__float_as_uint(v), __float_as_uint(v), false, false); return __uint_as_float(rr[0]) + __uint_as_float(rr[1]); }
__device__ __forceinline__ float pother(float v, int hi) { auto rr = __builtin_amdgcn_permlane32_swap(__float_as_uint(v), __float_as_uint(v), false, false); return hi ? __uint_as_float(rr[0]) : __uint_as_float(rr[1]); }
__device__ __forceinline__ s16x4 vtr(const LAS unsigned char* p) { return __builtin_bit_cast(s16x4, __builtin_amdgcn_ds_read_tr16_b64_v4i16((LAS v4i16_t*)p)); }

#define MASK_GT(x, K, v, neg) asm volatile("v_cmp_gt_i32_e32 vcc, %2, %1\n\tv_cndmask_b32_e32 %0, %0, %3, vcc" : "+v"(x) : "v"(v), "i"(K), "v"(neg) : "vcc")
#define MASK_LE(x, K, v, neg) asm volatile("v_cmp_le_i32_e32 vcc, %2, %1\n\tv_cndmask_b32_e32 %0, %0, %3, vcc" : "+v"(x) : "v"(v), "i"(K), "v"(neg) : "vcc")
struct TileSrc { const bf16_t* k; const bf16_t* v; int pitch; };
__device__ __forceinline__ void tile_load(const TileSrc& s, int wid, int lane, u32x4& kreg, u32x4& vreg) {
    kreg = *(const u32x4*)(s.k + (size_t)lane * s.pitch + wid * 8);
    vreg = *(const u32x4*)(s.v + (size_t)(16 * (wid & 3) + (lane >> 2)) * s.pitch + (wid >> 2) * 32 + (lane & 3) * 8);
}
__device__ __forceinline__ void tile_write(LAS unsigned char* lds, int buf, int wid, int lane, const u32x4& kreg, const u32x4& vreg) {
    *(LAS u32x4*)(lds + L_KV + buf * 16384 + wid * 1024 + lane * 16) = kreg;
    *(LAS u32x4*)(lds + L_KV + buf * 16384 + 8192 + wid * 1024 + lane * 16) = vreg;
}
__device__ __forceinline__ void qkt(f32x16& p0, f32x16& p1, const LAS unsigned char* kslot, const bf16x8 (&qr)[4], int r32, int hi) {
    const LAS unsigned char* kb = kslot + hi * 1024 + r32 * 16;
    p0 = f32x16{}; p1 = f32x16{};
#pragma unroll
    for (int d0 = 0; d0 < 4; ++d0) {
        const bf16x8 b0 = *(const LAS bf16x8*)(kb + d0 * 2048), b1 = *(const LAS bf16x8*)(kb + d0 * 2048 + 512);
        p0 = __builtin_amdgcn_mfma_f32_32x32x16_bf16(b0, qr[d0], p0, 0, 0, 0);
        p1 = __builtin_amdgcn_mfma_f32_32x32x16_bf16(b1, qr[d0], p1, 0, 0, 0);
    }
}
__device__ __forceinline__ void pv(f32x16 (&o)[2], const f32x16& p0, const f32x16& p1, const LAS unsigned char* vslot, int lane, int hi) {
    const LAS unsigned char* vp = vslot + ((lane >> 4) & 1) * 32 + (lane & 3) * 8 + (4 * hi + ((lane & 15) >> 2)) * 64;
    u32x4 pw[4];
    pw[0] = (u32x4){cvtpk(p0[0], p0[1]), cvtpk(p0[2], p0[3]), cvtpk(p0[4], p0[5]), cvtpk(p0[6], p0[7])};
    pw[1] = (u32x4){cvtpk(p0[8], p0[9]), cvtpk(p0[10], p0[11]), cvtpk(p0[12], p0[13]), cvtpk(p0[14], p0[15])};
    pw[2] = (u32x4){cvtpk(p1[0], p1[1]), cvtpk(p1[2], p1[3]), cvtpk(p1[4], p1[5]), cvtpk(p1[6], p1[7])};
    pw[3] = (u32x4){cvtpk(p1[8], p1[9]), cvtpk(p1[10], p1[11]), cvtpk(p1[12], p1[13]), cvtpk(p1[14], p1[15])};
#pragma unroll
    for (int dh = 0; dh < 2; ++dh) {
        __builtin_amdgcn_sched_barrier(0);
#pragma unroll
        for (int ks = 0; ks < 4; ++ks) {
            const s16x4 lo = vtr(vp + dh * 4096 + ks * 1024), hi4 = vtr(vp + dh * 4096 + ks * 1024 + 512);
            const bf16x8 vf = (bf16x8){lo[0], lo[1], lo[2], lo[3], hi4[0], hi4[1], hi4[2], hi4[3]};
            o[dh] = __builtin_amdgcn_mfma_f32_32x32x16_bf16(__builtin_bit_cast(bf16x8, pw[ks]), vf, o[dh], 0, 0, 0);
        }
    }
}
__device__ __forceinline__ void osm(f32x16& p0, f32x16& p1, f32x16 (&o)[2], float& m, float& l, LAS float* wsf, int r32, int hi) {
    float a = fmaxf(p0[0], p1[0]);
#pragma unroll
    for (int r = 1; r < 16; ++r) a = fmaxf(a, fmaxf(p0[r], p1[r]));
    const float rm = pmax(a);
    const float mn = fmaxf(m, rm);
    const float alpha = __builtin_amdgcn_exp2f(m - mn);
    if (__ballot(mn > m) != 0ull) {
        if (hi == 0) wsf[r32] = alpha;
#pragma unroll
        for (int r = 0; r < 16; ++r) { const float f = wsf[crow(r, hi)]; o[0][r] *= f; o[1][r] *= f; }
    }
    m = mn;
    float rs = 0.f;
#pragma unroll
    for (int r = 0; r < 16; ++r) { p0[r] = __builtin_amdgcn_exp2f(p0[r] - mn); p1[r] = __builtin_amdgcn_exp2f(p1[r] - mn); rs += p0[r] + p1[r]; }
    l = l * alpha + rs;
}
__device__ __forceinline__ void fold(f32x16 (&oacc)[2], const f32x16 (&o)[2], float fac, LAS float* wsf, int r32, int hi) {
    if (hi == 0) wsf[32 + r32] = fac;
#pragma unroll
    for (int r = 0; r < 16; ++r) { const float f = wsf[32 + crow(r, hi)]; oacc[0][r] += o[0][r] * f; oacc[1][r] += o[1][r] * f; }
}

__device__ __forceinline__ void attn_unit(const Frame& F, int bg, int c, const bf16_t* ZQ, const bf16_t* KCb, const bf16_t* VCb, const float* GATES, bf16_t* OATT, unsigned* SELM) {
    LAS unsigned char* lds = F.lds;
    asm volatile("" : "+s"(ZQ), "+s"(KCb), "+s"(VCb), "+s"(GATES), "+s"(OATT), "+s"(SELM));
    int lane = F.lane; const int wid = F.wave, j = wid >> 1, th = wid & 1;
    int r32 = lane & 31, hi = lane >> 5;
    const int b = bg >> 1, g = bg & 1, head = g * HPG + j;
    int ql = 32 * th + r32;
#define REFRESH() do { asm volatile("" : "+v"(lane)); r32 = lane & 31; hi = lane >> 5; ql = 32 * th + r32; } while (0)
    const int t = 64 * c + ql; const size_t m = (size_t)b * SEQ + t;
    LAS float* wsf = (LAS float*)(lds + L_WSF) + wid * 64;
    LAS unsigned* selm = (LAS unsigned*)(lds + L_SELM);
    const bf16_t* zb = ZQ + (size_t)b * SEQ * ZQP;
    bf16x8 qr[4];
    { const bf16_t* qp = ZQ + m * ZQP + head * HD + hi * 8;
#pragma unroll
      for (int d0 = 0; d0 < 4; ++d0) qr[d0] = *(const bf16x8*)(qp + d0 * 16); }
    const float* gr = GATES + m * GP;
    const float g0 = 1.f / (1.f + __expf(-gr[head])), g1 = 1.f / (1.f + __expf(-gr[8 + head])), g2 = 1.f / (1.f + __expf(-gr[16 + head]));
    f32x16 oacc[2]; oacc[0] = f32x16{}; oacc[1] = f32x16{};
    u32x4 kreg, vreg;
    if (F.tid == 0) selm[64] = 0u;
    {
        REFRESH();
        TileSrc s0{KCb + (size_t)bg * 128 * HD, VCb + (size_t)bg * 128 * HD, HD}, s1{KCb + ((size_t)bg * 128 + 64) * HD, VCb + ((size_t)bg * 128 + 64) * HD, HD};
        tile_load(s0, wid, lane, kreg, vreg); tile_write(lds, 0, wid, lane, kreg, vreg);
        tile_load(s1, wid, lane, kreg, vreg); tile_write(lds, 1, wid, lane, kreg, vreg);
        __syncthreads();
        f32x16 a0, a1, b0, b1;
        qkt(a0, a1, lds + L_KV, qr, r32, hi); qkt(b0, b1, lds + L_KV + 16384, qr, r32, hi);
        const int nmax = (t >= 31) ? ((t - 31) >> 4) : -1;
        { const int nv = nmax - 4 * hi; const float negv = NEG;
#pragma unroll
        for (int r = 0; r < 16; ++r) { MASK_GT(a0[r], crow(r, 0), nv, negv); MASK_GT(a1[r], crow(r, 0) + 32, nv, negv); MASK_GT(b0[r], crow(r, 0) + 64, nv, negv); MASK_GT(b1[r], crow(r, 0) + 96, nv, negv); } }
        float a = NEG;
#pragma unroll
        for (int r = 0; r < 16; ++r) a = fmaxf(fmaxf(a, fmaxf(a0[r], a1[r])), fmaxf(b0[r], b1[r]));
        const float rm = pmax(a);
        float rs = 0.f;
#pragma unroll
        for (int r = 0; r < 16; ++r) { a0[r] = __builtin_amdgcn_exp2f(a0[r] - rm); a1[r] = __builtin_amdgcn_exp2f(a1[r] - rm); b0[r] = __builtin_amdgcn_exp2f(b0[r] - rm); b1[r] = __builtin_amdgcn_exp2f(b1[r] - rm);
            rs += (a0[r] + a1[r]) + (b0[r] + b1[r]); }
        const float tot = psum(rs);
        const float inv = (nmax >= 0) ? 1.0f / tot : 0.f;
#pragma unroll
        for (int r = 0; r < 16; ++r) { a0[r] *= inv; a1[r] *= inv; b0[r] *= inv; b1[r] *= inv; }
        {
            LAS float* slab = (LAS float*)(lds + L_IMP) + wid * (32 * 33) + r32 * 33;
            float prevTp = 0.f;
#define IMP_Q(q, X, q4) do { const float S_ = (X[4 * (q4)] + X[4 * (q4) + 1]) + (X[4 * (q4) + 2] + X[4 * (q4) + 3]); const float Tp_ = pother(X[4 * (q4) + 3], hi); \
                slab[2 * (q) + hi] = S_ + (hi ? Tp_ : prevTp); prevTp = Tp_; } while (0)
#pragma unroll
            for (int q4 = 0; q4 < 4; ++q4) IMP_Q(q4, a0, q4);
#pragma unroll
            for (int q4 = 0; q4 < 4; ++q4) IMP_Q(4 + q4, a1, q4);
#pragma unroll
            for (int q4 = 0; q4 < 4; ++q4) IMP_Q(8 + q4, b0, q4);
#pragma unroll
            for (int q4 = 0; q4 < 4; ++q4) IMP_Q(12 + q4, b1, q4);
#undef IMP_Q
        }
#pragma unroll
        for (int r = 0; r < 16; ++r) { a0[r] *= g0; a1[r] *= g0; b0[r] *= g0; b1[r] *= g0; }
        pv(oacc, a0, a1, lds + L_KV + 8192, lane, hi); pv(oacc, b0, b1, lds + L_KV + 16384 + 8192, lane, hi);
    }
    __syncthreads();
    {
        REFRESH();
        const LAS float* imp = (const LAS float*)(lds + L_IMP);
        const int jj = lane & 31;
#pragma unroll 1
        for (int i = 0; i < 4; ++i) {
            const int tk = 8 * wid + 2 * i + hi, tth = tk >> 5, tr = tk & 31, tt = 64 * c + tk;
            const float v = (imp[(0 + tth) * (32 * 33) + tr * 33 + jj] + imp[(2 + tth) * (32 * 33) + tr * 33 + jj]) + (imp[(4 + tth) * (32 * 33) + tr * 33 + jj] + imp[(6 + tth) * (32 * 33) + tr * 33 + jj]);
            const int cur = tt >> 6; const bool valid = (64 * jj <= tt), forced = (jj == 0) || (jj == cur) || (jj == cur - 1);
            const float score = forced ? 1e9f : (valid ? v : -1e30f);
            int rank = 0;
#pragma unroll 1
            for (int jp = 0; jp < 32; ++jp) { const float sp = __shfl(score, jp, 32); rank += (sp > score || (sp == score && jp < jj)) ? 1 : 0; }
            const unsigned long long bal = __ballot(rank < 16);
            const unsigned mk = hi ? (unsigned)(bal >> 32) : (unsigned)(bal & 0xffffffffull);
            if (jj == 0) { selm[tk] = mk; atomicOr((unsigned*)(F.ldsg + L_SELM) + 64, mk); SELM[((size_t)b * SEQ + tt) * NG + g] = mk; }
        }
    }
    __syncthreads();
    REFRESH();
    const unsigned mymask = selm[ql];
    unsigned umask = selm[64] & (c >= 31 ? 0xffffffffu : ((2u << c) - 1u));
    {
        f32x16 o[2]; o[0] = f32x16{}; o[1] = f32x16{}; float mrun = NEG, l = 0.f;
        int jt = __builtin_ctz(umask);
        { TileSrc s{zb + (size_t)(64 * jt) * ZQP + 768 + g * HD, zb + (size_t)(64 * jt) * ZQP + 896 + g * HD, ZQP}; tile_load(s, wid, lane, kreg, vreg); }
        __syncthreads();
        tile_write(lds, 0, wid, lane, kreg, vreg);
        __syncthreads();
        int buf = 0;
        while (true) {
            unsigned rest = umask & ~((2u << jt) - 1u); if (jt >= 31) rest = 0u;
            const int jn = rest ? __builtin_ctz(rest) : -1;
            if (jn >= 0) { TileSrc s{zb + (size_t)(64 * jn) * ZQP + 768 + g * HD, zb + (size_t)(64 * jn) * ZQP + 896 + g * HD, ZQP}; tile_load(s, wid, lane, kreg, vreg); }
            f32x16 p0, p1;
            qkt(p0, p1, lds + L_KV + buf * 16384, qr, r32, hi);
            const bool rowsel = (mymask >> jt) & 1u;
            if (jt == c) {
                const int qv = ql - 4 * hi; const float negv = NEG;
#pragma unroll
                for (int r = 0; r < 16; ++r) { MASK_GT(p0[r], crow(r, 0), qv, negv); MASK_GT(p1[r], crow(r, 0) + 32, qv, negv); }
            }
            if (!rowsel) {
#pragma unroll
                for (int r = 0; r < 16; ++r) { p0[r] = NEG; p1[r] = NEG; }
            }
            osm(p0, p1, o, mrun, l, wsf, r32, hi);
            pv(o, p0, p1, lds + L_KV + buf * 16384 + 8192, lane, hi);
            if (jn < 0) break;
            tile_write(lds, buf ^ 1, wid, lane, kreg, vreg);
            __syncthreads();
            buf ^= 1; jt = jn;
        }
        fold(oacc, o, g1 / psum(l), wsf, r32, hi);
    }
    {
        REFRESH();
        f32x16 o[2]; o[0] = f32x16{}; o[1] = f32x16{}; float mrun = NEG, l = 0.f;
        int jt = c >= 8 ? c - 8 : 0;
        { TileSrc s{zb + (size_t)(64 * jt) * ZQP + 1024 + g * HD, zb + (size_t)(64 * jt) * ZQP + 1152 + g * HD, ZQP}; tile_load(s, wid, lane, kreg, vreg); }
        __syncthreads();
        tile_write(lds, 0, wid, lane, kreg, vreg);
        __syncthreads();
        int buf = 0;
        while (true) {
            const int jn = (jt < c) ? jt + 1 : -1;
            if (jn >= 0) { TileSrc s{zb + (size_t)(64 * jn) * ZQP + 1024 + g * HD, zb + (size_t)(64 * jn) * ZQP + 1152 + g * HD, ZQP}; tile_load(s, wid, lane, kreg, vreg); }
            f32x16 p0, p1;
            qkt(p0, p1, lds + L_KV + buf * 16384, qr, r32, hi);
            if (jt == c) {
                const int qv = ql - 4 * hi; const float negv = NEG;
#pragma unroll
                for (int r = 0; r < 16; ++r) { MASK_GT(p0[r], crow(r, 0), qv, negv); MASK_GT(p1[r], crow(r, 0) + 32, qv, negv); }
            } else if (jt == c - 8) {
                const int qv = ql - 4 * hi; const float negv = NEG;
#pragma unroll
                for (int r = 0; r < 16; ++r) { MASK_LE(p0[r], crow(r, 0), qv, negv); MASK_LE(p1[r], crow(r, 0) + 32, qv, negv); }
            }
            osm(p0, p1, o, mrun, l, wsf, r32, hi);
            pv(o, p0, p1, lds + L_KV + buf * 16384 + 8192, lane, hi);
            if (jn < 0) break;
            tile_write(lds, buf ^ 1, wid, lane, kreg, vreg);
            __syncthreads();
            buf ^= 1; jt = jn;
        }
        fold(oacc, o, g2 / psum(l), wsf, r32, hi);
    }
    {
        REFRESH();
        LAS bf16_t* stg = (LAS bf16_t*)(lds + L_IMP) + wid * 2048;
#pragma unroll
        for (int r = 0; r < 16; ++r) { const int orow = crow(r, hi);
#pragma unroll
            for (int dh = 0; dh < 2; ++dh) stg[orow * 64 + dh * 32 + r32] = f2bf(oacc[dh][r]); }
        bf16_t* Ow = OATT + ((size_t)b * SEQ + 64 * c + 32 * th) * DM + head * HD;
#pragma unroll
        for (int i = 0; i < 4; ++i) { const int row = i * 8 + (lane >> 3), ch = lane & 7; const u32x4 v = *(const LAS u32x4*)(stg + row * 64 + ch * 8); *(u32x4*)(Ow + (size_t)row * DM + ch * 8) = v; }
    }
    __syncthreads();
#undef REFRESH
}
__device__ __forceinline__ void attn_phase(const Frame& F, const bf16_t* ZQ, const bf16_t* KCb, const bf16_t* VCb, const float* GATES, bf16_t* OATT, unsigned* SELM) {
    for (int v = F.vcu; v < 256; v += F.G) {
        const int bg = v >> 4, s = v & 15;
#pragma unroll 1
        for (int u = 0; u < 2; ++u) attn_unit(F, bg, u ? s : 31 - s, ZQ, KCb, VCb, GATES, OATT, SELM);
    }
}
}
__device__ __forceinline__ int map_row(int n, int mode) {
    if (mode == 1) return n < 1280 ? n : (n < 1304 ? 2816 + (n - 1280) : 1280 + (n - 1304));
    if (mode == 2) return (n >> 7) * 256 + (n & 127);
    if (mode == 3) return (n >> 7) * 256 + 128 + (n & 127);
    return n;
}
__device__ __forceinline__ void p0_transpose_item(const float* W, int K, int N, bf16_t* WT, int mode, LAS float* scr, int item, int lane) {
    const int nblk = (N + 31) / 32, kb = item / nblk, nb = item % nblk, k0 = 64 * kb, n0 = 32 * nb;
    const int nl = n0 + (lane & 31); const bool okl = nl < N;
#pragma unroll 8
    for (int i = 0; i < 32; ++i) { const int kk = 2 * i + (lane >> 5); scr[kk * 33 + (lane & 31)] = okl ? W[(size_t)(k0 + kk) * N + nl] : 0.f; }
    LDS_WAIT(); asm volatile("" ::: "memory");
    const int c = lane & 7;
#pragma unroll
    for (int j = 0; j < 4; ++j) { const int n = (lane >> 3) + 8 * j; const LAS float* s = scr + (8 * c) * 33 + n;
        uint4 o; o.x = pk2(s[0 * 33], s[1 * 33]); o.y = pk2(s[2 * 33], s[3 * 33]); o.z = pk2(s[4 * 33], s[5 * 33]); o.w = pk2(s[6 * 33], s[7 * 33]);
        if (n0 + n < N) *(uint4*)(WT + (size_t)map_row(n0 + n, mode) * K + k0 + 8 * c) = o; }
    LDS_WAIT(); asm volatile("" ::: "memory");
}
struct LnP { const float* X; const float* TMP; const bf16_t* TMPB; const bf16_t* PO; const int* tope; const float* topw; const unsigned* cnt; const float* g; const float* b; float* HF; bf16_t* HB; };
template <int MODE> __device__ __forceinline__ void ln_row(const LnP& a, int m, int lane, float4 (&o)[4]) {
    float4 v[4];
    if (MODE == 0) {
#pragma unroll
        for (int j = 0; j < 4; ++j) v[j] = ((const float4*)(a.X + (size_t)m * DM))[64 * j + lane];
    } else {
#pragma unroll
        for (int j = 0; j < 4; ++j) { float4 h = ((const float4*)(a.HF + (size_t)m * DM))[64 * j + lane]; v[j] = make_float4(ALPHA * h.x, ALPHA * h.y, ALPHA * h.z, ALPHA * h.w); }
        if (MODE == 1) {
#pragma unroll
            for (int j = 0; j < 4; ++j) { float4 t = ((const float4*)(a.TMP + (size_t)m * DM))[64 * j + lane]; v[j].x += t.x; v[j].y += t.y; v[j].z += t.z; v[j].w += t.w; }
        } else if (MODE == 3) {
            const bf16_t* row = a.TMPB + (size_t)m * DM;
#pragma unroll
            for (int j = 0; j < 4; ++j) { const uint2 t = ((const uint2*)row)[64 * j + lane];
                v[j].x += bf2f((bf16_t)(t.x & 0xffff)); v[j].y += bf2f((bf16_t)(t.x >> 16)); v[j].z += bf2f((bf16_t)(t.y & 0xffff)); v[j].w += bf2f((bf16_t)(t.y >> 16)); }
        } else {
            int pre[NEXP]; int acc = 0;
#pragma unroll
            for (int e = 0; e < NEXP; ++e) { pre[e] = acc; acc += (int)a.cnt[e]; }
#pragma unroll
            for (int k = 0; k < 2; ++k) {
                const int ep = a.tope[m * 2 + k], e = ep & 255, pos = ep >> 8; const float wk = a.topw[m * 2 + k];
                int p = pos;
#pragma unroll
                for (int e2 = 0; e2 < NEXP; ++e2) if (e2 == e) p += pre[e2];
                const bf16_t* row = a.PO + (size_t)p * DM;
#pragma unroll
                for (int j = 0; j < 4; ++j) { const uint2 t = ((const uint2*)row)[64 * j + lane];
                    v[j].x += wk * bf2f((bf16_t)(t.x & 0xffff)); v[j].y += wk * bf2f((bf16_t)(t.x >> 16)); v[j].z += wk * bf2f((bf16_t)(t.y & 0xffff)); v[j].w += wk * bf2f((bf16_t)(t.y >> 16)); }
            }
        }
    }
    float s = 0.f;
#pragma unroll
    for (int j = 0; j < 4; ++j) s += (v[j].x + v[j].y) + (v[j].z + v[j].w);
    const float mean = wave_sum(s) * (1.f / DM);
    float q = 0.f;
#pragma unroll
    for (int j = 0; j < 4; ++j) { v[j].x -= mean; v[j].y -= mean; v[j].z -= mean; v[j].w -= mean; q += (v[j].x * v[j].x + v[j].y * v[j].y) + (v[j].z * v[j].z + v[j].w * v[j].w); }
    const float rstd = 1.0f / sqrtf(wave_sum(q) * (1.f / DM) + LN_EPS);
#pragma unroll
    for (int j = 0; j < 4; ++j) {
        const float4 g = ((const float4*)a.g)[64 * j + lane], b = ((const float4*)a.b)[64 * j + lane];
        o[j] = make_float4(v[j].x * rstd * g.x + b.x, v[j].y * rstd * g.y + b.y, v[j].z * rstd * g.z + b.z, v[j].w * rstd * g.w + b.w);
        ((float4*)(a.HF + (size_t)m * DM))[64 * j + lane] = o[j];
        if (MODE != 2) { uint2 pk; pk.x = pk2(o[j].x, o[j].y); pk.y = pk2(o[j].z, o[j].w); ((uint2*)(a.HB + (size_t)m * DM))[64 * j + lane] = pk; }
    }
}
__device__ __forceinline__ void route_row(const float4 (&o)[4], int m, int lane, const float* Wr, unsigned* cnt, int* tope, float* topw, int* list) {
    float lg[NEXP];
#pragma unroll
    for (int e = 0; e < NEXP; ++e) lg[e] = 0.f;
#pragma unroll
    for (int j = 0; j < 4; ++j) {
        const float hv[4] = {o[j].x, o[j].y, o[j].z, o[j].w};
#pragma unroll
        for (int i = 0; i < 4; ++i) { const int d = 256 * j + 4 * lane + i; const float4 w0 = ((const float4*)(Wr + (size_t)d * NEXP))[0], w1 = ((const float4*)(Wr + (size_t)d * NEXP))[1];
            lg[0] += hv[i] * w0.x; lg[1] += hv[i] * w0.y; lg[2] += hv[i] * w0.z; lg[3] += hv[i] * w0.w; lg[4] += hv[i] * w1.x; lg[5] += hv[i] * w1.y; lg[6] += hv[i] * w1.z; lg[7] += hv[i] * w1.w; }
    }
#pragma unroll
    for (int e = 0; e < NEXP; ++e) lg[e] = wave_sum(lg[e]);
    if (lane == 0) {
        int i0 = 0; float b0 = lg[0];
#pragma unroll
        for (int e = 1; e < NEXP; ++e) if (lg[e] > b0) { b0 = lg[e]; i0 = e; }
        int i1 = -1; float b1 = -INFINITY;
#pragma unroll
        for (int e = 0; e < NEXP; ++e) if (e != i0 && lg[e] > b1) { b1 = lg[e]; i1 = e; }
        const float e1 = expf(b1 - b0), w0 = 1.f / (1.f + e1), w1 = e1 / (1.f + e1);
        const unsigned p0 = atomicAdd(&cnt[i0], 1u), p1 = atomicAdd(&cnt[i1], 1u);
        list[i0 * MTOK + p0] = m; list[i1 * MTOK + p1] = m;
        tope[m * 2] = i0 | ((int)p0 << 8); tope[m * 2 + 1] = i1 | ((int)p1 << 8);
        topw[m * 2] = w0; topw[m * 2 + 1] = w1;
    }
}

__device__ __forceinline__ void compress_items(const Frame& F, const bf16_t* ZQ, const float* pos, const float* w1, const float* b1, const float* w2, const float* b2, bf16_t* KC) {
    const int hb = F.tid >> 8, t256 = F.tid & 255;
    float* win = (float*)(F.ldsg + hb * 16384); float* hid = win + 2048;
    constexpr int NIT = 2 * BATCH * NG * 128;
    for (int base = F.vcu * 2; base < NIT; base += 2 * F.G) {
        const int item = base + hb;
        const int i = item & 127, bg = (item >> 7) % (BATCH * NG), kv = item / (128 * BATCH * NG);
        const int b = bg / NG, g = bg % NG;
        __syncthreads();
        if (i < NCMP) for (int k = t256; k < 2048; k += 256) { const int r = k >> 6, d = k & 63;
            win[k] = bf2f(ZQ[(size_t)(b * SEQ + 16 * i + r) * ZQP + 512 + kv * 128 + g * 64 + d]) + pos[kv * 2048 + k]; }
        __syncthreads();
        if (i < NCMP) {
            float acc = b1[kv * CMPH + t256];
            const float* w = w1 + (size_t)kv * 2048 * CMPH + t256;
            for (int k = 0; k < 2048; ++k) acc += win[k] * w[(size_t)k * CMPH];
            const float x = acc;
            hid[t256] = 0.5f * x * (1.f + tanhf(0.7978845608028654f * (x + 0.044715f * x * x * x)));
        }
        __syncthreads();
        if (t256 < 64) { float o = 0.f;
            if (i < NCMP) { o = b2[kv * HD + t256]; const float* ww = w2 + (size_t)kv * CMPH * HD + t256; for (int n = 0; n < CMPH; ++n) o += hid[n] * ww[n * HD]; }
            KC[((size_t)(kv * BATCH * NG + bg) * 128 + i) * HD + t256] = f2bf(o); }
    }
}
__device__ __forceinline__ void conv_items(const Frame& F, const bf16_t* ZC, const float* cw, bf16_t* OATT) {
    for (size_t idx = (size_t)F.vcu * NTHR + F.tid; idx < (size_t)MTOK * 512; idx += (size_t)F.G * NTHR) {
        const int ch = (int)(idx & 511); const size_t m = idx >> 9; const int t = (int)(m % SEQ);
        float y = 0.f;
#pragma unroll
        for (int i = 0; i < 3; ++i) { const int dt = 2 - i; if (t - dt >= 0) { const bf16_t* r = ZC + (m - dt) * ZCP; y += bf2f(r[1024 + ch]) * bf2f(r[ch]) * cw[i * 512 + ch]; } }
        OATT[m * DM + 512 + ch] = f2bf(bf2f(ZC[m * ZCP + 512 + ch]) * y);
    }
}

template <int MODE> __device__ __forceinline__ void moe_naive(const Frame& F, const bf16_t* A, const bf16_t* B, bf16_t* O, const unsigned* cnt, const int* list) {
    constexpr bool DUAL = (MODE == 4);
    constexpr int K = (MODE == 4) ? DM : DFFE, NT = (MODE == 4) ? DFFE / 64 : DM / 64;
    const int hb = F.tid >> 8, tid = F.tid & 255, tx = tid & 15, ty = tid >> 4;
    float (*As)[68] = (float (*)[68])(F.ldsg + hb * 32768); float (*Bs)[68] = As + 32; float (*Bs2)[68] = Bs + 32;
    int cn[NEXP], tpre[NEXP + 1], rpre[NEXP]; { int ta = 0, ra = 0;
#pragma unroll
        for (int e = 0; e < NEXP; ++e) { cn[e] = (int)cnt[e]; tpre[e] = ta; rpre[e] = ra; ta += (cn[e] + 63) >> 6; ra += cn[e]; } tpre[NEXP] = ta; }
    const int nitems = tpre[NEXP] * NT;
    for (int base = F.vcu * 2; base < nitems; base += 2 * F.G) {
        const int item = base + hb; const bool valid = item < nitems;
        const int tile = valid ? item / NT : 0, n0 = valid ? (item % NT) * 64 : 0;
        int e = 0, rt = tile, ce = cn[0], pre = 0;
#pragma unroll
        for (int e2 = 1; e2 < NEXP; ++e2) if (tile >= tpre[e2]) { e = e2; rt = tile - tpre[e2]; ce = cn[e2]; pre = rpre[e2]; }
        const int rows_valid = min(64, ce - rt * 64), prow0 = pre + rt * 64;
        const bf16_t* Bb = B + (size_t)e * (MODE == 4 ? (size_t)2 * DFFE * DM : (size_t)DM * DFFE);
        const int lr = tid >> 2, lc = (tid & 3) * 8;
        const bf16_t* arow;
        if (MODE == 4) { const int tok = (valid && lr < rows_valid) ? list[e * MTOK + rt * 64 + lr] : 0; arow = A + (size_t)tok * K; }
        else { int p = prow0 + lr; if (p > 2 * MTOK - 1) p = 2 * MTOK - 1; arow = A + (size_t)p * K; }
        const int nl = n0 + lr;
        const bf16_t* brow = DUAL ? Bb + (size_t)((nl >> 7) * 256 + (nl & 127)) * K : Bb + (size_t)nl * K;
        const bf16_t* brow2 = DUAL ? brow + (size_t)128 * K : brow;
        float acc[4][4], acc2[4][4];
#pragma unroll
        for (int i = 0; i < 4; ++i)
#pragma unroll
            for (int jx = 0; jx < 4; ++jx) { acc[i][jx] = 0.f; acc2[i][jx] = 0.f; }
        for (int k0 = 0; k0 < K; k0 += 32) {
            const uint4 av = *(const uint4*)(arow + k0 + lc);
            const uint4 bv = *(const uint4*)(brow + k0 + lc);
            uint4 bv2 = bv; if (DUAL) bv2 = *(const uint4*)(brow2 + k0 + lc);
            __syncthreads();
            const unsigned aw[4] = {av.x, av.y, av.z, av.w}, bw[4] = {bv.x, bv.y, bv.z, bv.w}, bw2[4] = {bv2.x, bv2.y, bv2.z, bv2.w};
#pragma unroll
            for (int i = 0; i < 4; ++i) {
                As[lc + 2 * i][lr] = __uint_as_float(aw[i] << 16); As[lc + 2 * i + 1][lr] = __uint_as_float(aw[i] & 0xffff0000u);
                Bs[lc + 2 * i][lr] = __uint_as_float(bw[i] << 16); Bs[lc + 2 * i + 1][lr] = __uint_as_float(bw[i] & 0xffff0000u);
                if (DUAL) { Bs2[lc + 2 * i][lr] = __uint_as_float(bw2[i] << 16); Bs2[lc + 2 * i + 1][lr] = __uint_as_float(bw2[i] & 0xffff0000u); }
            }
            __syncthreads();
#pragma unroll 8
            for (int k = 0; k < 32; ++k) {
                const float4 a4 = *(const float4*)&As[k][ty * 4];
                const float4 b4 = *(const float4*)&Bs[k][tx * 4];
                const float af[4] = {a4.x, a4.y, a4.z, a4.w}, bf[4] = {b4.x, b4.y, b4.z, b4.w};
#pragma unroll
                for (int i = 0; i < 4; ++i)
#pragma unroll
                    for (int jx = 0; jx < 4; ++jx) acc[i][jx] += af[i] * bf[jx];
                if (DUAL) {
                    const float4 c4 = *(const float4*)&Bs2[k][tx * 4];
                    const float cf[4] = {c4.x, c4.y, c4.z, c4.w};
#pragma unroll
                    for (int i = 0; i < 4; ++i)
#pragma unroll
                        for (int jx = 0; jx < 4; ++jx) acc2[i][jx] += af[i] * cf[jx];
                }
            }
        }
        if (valid) {
#pragma unroll
            for (int i = 0; i < 4; ++i) {
                const int r = ty * 4 + i;
                if (r < rows_valid) {
                    const size_t mrow = (size_t)(prow0 + r);
#pragma unroll
                    for (int jx = 0; jx < 4; ++jx) {
                        const int n = n0 + tx * 4 + jx; const float v = acc[i][jx];
                        if (MODE == 4) { const float u = acc2[i][jx]; O[mrow * DFFE + n] = f2bf(v / (1.f + expf(-v)) * u); }
                        else O[mrow * DM + n] = f2bf(v);
                    }
                }
            }
        }
    }
}

constexpr int NPHASE = 17;
__global__ void __launch_bounds__(NTHR, 2) mega_fwd(Args args) {
    extern __shared__ __attribute__((aligned(16))) unsigned char lds[];
    Frame F;
    F.lds = (LAS unsigned char*)lds; F.ldsg = lds;
    F.MISC = (volatile LAS unsigned*)(F.lds + MISC_OFF);
    F.tid = threadIdx.x; F.lane = F.tid & 63; F.wave = __builtin_amdgcn_readfirstlane(F.tid >> 6);
    F.G = gridDim.x; { const int bx = blockIdx.x; F.vcu = (F.G % 8 == 0) ? (bx % 8) * (F.G / 8) + bx / 8 : bx; }
    for (int u = F.tid; u < (LDS_BYTES - LDSCTL_OFF) / 4; u += NTHR) ((LAS unsigned*)(F.lds + LDSCTL_OFF))[u] = 0u;
    __syncthreads();
    const int lo = args.ph_lo, hi = args.ph_hi;
    F.ctl = nullptr;
    const bool one_launch = (hi - lo) > 1;
#define KA() ({ const __attribute__((address_space(4))) Args* p_ = (const __attribute__((address_space(4))) Args*)__builtin_amdgcn_kernarg_segment_ptr(); asm volatile("" : "+s"(p_)); p_; })
#define WS(off) (KA()->ws + (off))
#define INP(i) (KA()->in[i])
    XcdBarrier bar; bar.bar = nullptr; bar.x = 0; bar.st = nullptr;
    if (one_launch) bar = xcd_barrier_post((unsigned*)WS(OFF_CTL) + CW_BAR, F.MISC + 8);
#define IN(k) ({ int lo_ = lo, hi_ = hi; asm volatile("" : "+s"(lo_), "+s"(hi_)); (lo_ <= (k) && (k) < hi_); })
#define FRESH() do { asm volatile("" : "+v"(F.tid)); F.lane = F.tid & 63; } while (0)
#define SEAM(k) do { if (IN(k) && IN((k) + 1)) { XcdBarrier b2_; b2_.bar = (unsigned*)WS(OFF_CTL) + CW_BAR; b2_.x = bar.x; b2_.st = bar.st; xcd_barrier(b2_); } } while (0)
    const int gw = F.vcu * NWAVES + F.wave, NGW = F.G * NWAVES;

    if (IN(0)) { FRESH();
        LAS float* scr = (LAS float*)(F.lds + RING_OFF + F.wave * 16384);
        bf16_t* WIN_T = (bf16_t*)WS(OFF_WIN_T);
        for (int l = 0; l < DEPTH; ++l) { uint4* p = (uint4*)(WIN_T + (size_t)l * DINP * DM + (size_t)DIN * DM); const int n16 = (DINP - DIN) * DM * 2 / 16;
            for (int i = F.vcu * NTHR + F.tid; i < n16; i += F.G * NTHR) p[i] = make_uint4(0, 0, 0, 0); }
        int it0 = gw;
#define P0_TASK(Wp, K_, N_, WTp, mode_) do { const int nit_ = ((K_) / 64) * (((N_) + 31) / 32); \
            for (; it0 < nit_; it0 += NGW) p0_transpose_item((Wp), (K_), (N_), (WTp), (mode_), scr, it0, F.lane); it0 -= nit_; } while (0)
        for (int l = 0; l < DEPTH; ++l) {
            P0_TASK(INP(3) + (size_t)l * DM * DIN, DM, DIN, (bf16_t*)WS(OFF_WIN_T) + (size_t)l * DINP * DM, 1);
            P0_TASK(INP(10) + (size_t)l * DM * DM, DM, DM, (bf16_t*)WS(OFF_WO_T) + (size_t)l * DM * DM, 0);
        }
        P0_TASK(INP(15), DM, DFF, (bf16_t*)WS(OFF_FGU_T), 2);
        P0_TASK(INP(16), DM, DFF, (bf16_t*)WS(OFF_FGU_T), 3);
        P0_TASK(INP(17), DFF, DM, (bf16_t*)WS(OFF_FD_T), 0);
        for (int e = 0; e < NEXP; ++e) {
            P0_TASK(INP(19) + (size_t)e * DM * DFFE, DM, DFFE, (bf16_t*)WS(OFF_MGU_T) + (size_t)e * 2 * DFFE * DM, 2);
            P0_TASK(INP(20) + (size_t)e * DM * DFFE, DM, DFFE, (bf16_t*)WS(OFF_MGU_T) + (size_t)e * 2 * DFFE * DM, 3);
            P0_TASK(INP(21) + (size_t)e * DFFE * DM, DFFE, DM, (bf16_t*)WS(OFF_MD_T) + (size_t)e * DM * DFFE, 0);
        }
#undef P0_TASK
        LnP a{}; a.X = INP(0); a.g = INP(1); a.b = INP(2); a.HF = KA()->out; a.HB = (bf16_t*)WS(OFF_HB);
        for (int m = gw; m < MTOK; m += NGW) { float4 o[4]; ln_row<0>(a, m, F.lane, o); }
    }
    SEAM(0);
    for (int l = 0; l < DEPTH; ++l) {
        const int pb = 1 + 8 * l;
        if (IN(pb + 0)) { FRESH();
            pg8::APlain ap{(const char*)WS(OFF_HB), (unsigned)DM * 2u}; pg8::StaticOrder S; S.init(MTOK / 256, DINP / 256, F.G, (int)blockIdx.x);
            pg8::EpiWin E{(bf16_t*)WS(OFF_ZQ), (bf16_t*)WS(OFF_ZC), (float*)WS(OFF_GATES)};
            pg8::gemm_phase<pg8::EpiWin, pg8::APlain, pg8::StaticOrder, true>(F.lds + RING_OFF, ap, (const bf16_t*)WS(OFF_WIN_T) + (size_t)l * DINP * DM, DM, S, E, F.tid);
        }
        SEAM(pb + 0);
        if (IN(pb + 1)) { FRESH();
            compress_items(F, (const bf16_t*)WS(OFF_ZQ), INP(4) + (size_t)l * 2 * 2048, INP(5) + (size_t)l * 2 * 2048 * CMPH, INP(6) + (size_t)l * 2 * CMPH, INP(7) + (size_t)l * 2 * CMPH * HD, INP(8) + (size_t)l * 2 * HD, (bf16_t*)WS(OFF_KC));
            conv_items(F, (const bf16_t*)WS(OFF_ZC), INP(9) + (size_t)l * 3 * 512, (bf16_t*)WS(OFF_OATT));
        }
        SEAM(pb + 1);
        if (IN(pb + 2)) { FRESH(); __syncthreads(); att::attn_phase(F, (const bf16_t*)WS(OFF_ZQ), (const bf16_t*)WS(OFF_KC), (const bf16_t*)WS(OFF_KC) + (size_t)BATCH * NG * 128 * HD, (const float*)WS(OFF_GATES), (bf16_t*)WS(OFF_OATT), (unsigned*)WS(OFF_SELM)); }
        SEAM(pb + 2);
        if (IN(pb + 3)) { FRESH();
            __syncthreads();
            pg8::APlain ap{(const char*)WS(OFF_OATT), (unsigned)DM * 2u}; pg8::StaticOrder S; S.init(MTOK / 256, DM / 256, F.G, (int)blockIdx.x);
            pg8::EpiF32 E{(float*)WS(OFF_ZQ), DM};
            pg8::gemm_phase<pg8::EpiF32, pg8::APlain, pg8::StaticOrder, true>(F.lds + RING_OFF, ap, (const bf16_t*)WS(OFF_WO_T) + (size_t)l * DM * DM, DM, S, E, F.tid);
        }
        SEAM(pb + 3);
        if (IN(pb + 4)) { FRESH();
            LnP a{}; a.TMP = (const float*)WS(OFF_ZQ); a.g = INP(11) + l * DM; a.b = INP(12) + l * DM; a.HF = KA()->out; a.HB = (bf16_t*)WS(OFF_HB);
            const float* Wr = INP(18); unsigned* cnt = (unsigned*)WS(OFF_CTL) + CW_CNT; int* TOPE = (int*)WS(OFF_TOPE); float* TOPW = (float*)WS(OFF_TOPW); int* LIST = (int*)WS(OFF_LIST);
            for (int m = gw; m < MTOK; m += NGW) { float4 o[4]; ln_row<1>(a, m, F.lane, o); if (l & 1) route_row(o, m, F.lane, Wr, cnt, TOPE, TOPW, LIST); }
        }
        SEAM(pb + 4);
        if ((l & 1) == 0) {
            if (IN(pb + 5)) { FRESH();
                pg8::APlain ap{(const char*)WS(OFF_HB), (unsigned)DM * 2u}; pg8::StaticOrder S; S.init(MTOK / 256, 2 * DFF / 256, F.G, (int)blockIdx.x);
                pg8::EpiSwiglu E{(bf16_t*)WS(OFF_ZQ), DFF};
                pg8::gemm_phase<pg8::EpiSwiglu, pg8::APlain, pg8::StaticOrder, true>(F.lds + RING_OFF, ap, (const bf16_t*)WS(OFF_FGU_T), DM, S, E, F.tid);
            }
            SEAM(pb + 5);
            if (IN(pb + 6)) { FRESH();
                pg8::APlain ap{(const char*)WS(OFF_ZQ), (unsigned)DFF * 2u}; pg8::StaticOrder S; S.init(MTOK / 256, DM / 256, F.G, (int)blockIdx.x);
                pg8::EpiBf16 E{(bf16_t*)WS(OFF_OATT), DM};
                pg8::gemm_phase<pg8::EpiBf16, pg8::APlain, pg8::StaticOrder, true>(F.lds + RING_OFF, ap, (const bf16_t*)WS(OFF_FD_T), DFF, S, E, F.tid);
            }
            SEAM(pb + 6);
            if (IN(pb + 7)) { FRESH();
                LnP a{}; a.TMPB = (const bf16_t*)WS(OFF_OATT); a.g = INP(13) + l * DM; a.b = INP(14) + l * DM; a.HF = KA()->out; a.HB = (bf16_t*)WS(OFF_HB);
                for (int m = gw; m < MTOK; m += NGW) { float4 o[4]; ln_row<3>(a, m, F.lane, o); }
            }
            SEAM(pb + 7);
        } else {
            if (IN(pb + 5)) { FRESH(); __syncthreads(); moe_naive<4>(F, (const bf16_t*)WS(OFF_HB), (const bf16_t*)WS(OFF_MGU_T), (bf16_t*)WS(OFF_ZQ), (const unsigned*)WS(OFF_CTL) + CW_CNT, (const int*)WS(OFF_LIST)); }
            SEAM(pb + 5);
            if (IN(pb + 6)) { FRESH(); __syncthreads(); moe_naive<5>(F, (const bf16_t*)WS(OFF_ZQ), (const bf16_t*)WS(OFF_MD_T), (bf16_t*)WS(OFF_HB), (const unsigned*)WS(OFF_CTL) + CW_CNT, (const int*)WS(OFF_LIST)); }
            SEAM(pb + 6);
            if (IN(pb + 7)) { FRESH();
                LnP a{}; a.PO = (const bf16_t*)WS(OFF_HB); a.tope = (const int*)WS(OFF_TOPE); a.topw = (const float*)WS(OFF_TOPW); a.cnt = (const unsigned*)WS(OFF_CTL) + CW_CNT; a.g = INP(13) + l * DM; a.b = INP(14) + l * DM; a.HF = KA()->out; a.HB = (bf16_t*)WS(OFF_HB);
                for (int m = gw; m < MTOK; m += NGW) { float4 o[4]; ln_row<2>(a, m, F.lane, o); }
            }
            SEAM(pb + 7);
        }
    }
#undef IN
#undef FRESH
#undef SEAM
#undef KA
#undef WS
#undef INP
}

#ifndef MK_N_LAUNCHES
#define MK_N_LAUNCHES 1
#endif
extern "C" void kernel_launch(void* const* d_in, const int* in_sizes, int n_in, void* d_out, int out_size, void* d_ws, size_t ws_size, hipStream_t stream) {
    (void)in_sizes; (void)out_size; (void)ws_size;
    static int grid = 0;
    if (grid == 0) {
        int dev = 0, cus = 0, per_cu = 0;
        if (n_in != 22 || hipGetDevice(&dev) != hipSuccess || hipDeviceGetAttribute(&cus, hipDeviceAttributeMultiprocessorCount, dev) != hipSuccess) { grid = -1; return; }
        if (hipFuncSetAttribute((const void*)mega_fwd, hipFuncAttributeMaxDynamicSharedMemorySize, LDS_BYTES) != hipSuccess) { grid = -1; return; }
        if (hipOccupancyMaxActiveBlocksPerMultiprocessor(&per_cu, (const void*)mega_fwd, NTHR, LDS_BYTES) != hipSuccess || per_cu < 1) { grid = -1; return; }
        (void)hipGetLastError();
        grid = cus;
    }
    if (grid < 0) return;
    (void)hipMemsetAsync((char*)d_ws + OFF_CTL, 0, CTL_ZERO_BYTES, stream);
    Args a{};
    for (int i = 0; i < 22; ++i) a.in[i] = (const float*)d_in[i];
    a.out = (float*)d_out; a.ws = (unsigned char*)d_ws;
    if (MK_N_LAUNCHES == 1) {
        a.ph_lo = 0; a.ph_hi = NPHASE;
        void* kargs[] = {&a};
        (void)hipLaunchCooperativeKernel((const void*)mega_fwd, dim3(grid), dim3(NTHR), kargs, LDS_BYTES, stream);
    } else {
        for (int p = 0; p < NPHASE; ++p) { a.ph_lo = p; a.ph_hi = p + 1; hipLaunchKernelGGL(mega_fwd, dim3(grid), dim3(NTHR), LDS_BYTES, stream, a); }
    }
}
```

```cpp
#include <hip/hip_runtime.h>
#include <stdint.h>
#include <math.h>

typedef unsigned short bf16_t;
#define LAS __attribute__((address_space(3)))
#define GAS __attribute__((address_space(1)))

constexpr int DM = 1024, BATCH = 8, SEQ = 2048, DEPTH = 2;
constexpr int MTOK = BATCH * SEQ;
constexpr int NH = 8, NG = 2, HPG = 4, HD = 64;
constexpr int DIN = 2840, DINP = 3072;
constexpr int NCMP = 127, CMPH = 256;
constexpr int DFF = 2816, NEXP = 8, DFFE = 1408;
constexpr int ZQP = 1280;
constexpr int ZCP = 1536;
constexpr int GP = 32;
constexpr float ALPHA = 1.41421356237309515f;
constexpr float LN_EPS = 1e-5f;
constexpr int NWAVES = 8, NTHR = 512;

constexpr size_t OFF_CTL = 0;
constexpr size_t SZ_WIN_T = (size_t)DINP * DM * 2;
constexpr size_t OFF_WIN_T = 1u << 20;
constexpr size_t OFF_CW1_T = OFF_WIN_T + 2 * SZ_WIN_T;
constexpr size_t OFF_WO_T = OFF_CW1_T + 4 * 1048576;
constexpr size_t OFF_FGU_T = OFF_WO_T + 2 * 2097152;
constexpr size_t OFF_FD_T = OFF_FGU_T + (size_t)2 * DFF * DM * 2;
constexpr size_t OFF_MGU_T = OFF_FD_T + (size_t)DM * DFF * 2;
constexpr size_t OFF_MD_T = OFF_MGU_T + (size_t)NEXP * 2 * DFFE * DM * 2;
constexpr size_t OFF_HB = OFF_MD_T + (size_t)NEXP * DM * DFFE * 2;
constexpr size_t OFF_OATT = OFF_HB + (size_t)MTOK * DM * 2;
constexpr size_t OFF_ZQ = OFF_OATT + (size_t)MTOK * DM * 2;
constexpr size_t OFF_ZC = OFF_ZQ + (size_t)MTOK * ZQP * 2;
constexpr size_t OFF_GATES = OFF_ZC + (size_t)MTOK * ZCP * 2;
constexpr size_t OFF_KC = OFF_GATES + (size_t)MTOK * GP * 4;
constexpr size_t OFF_SELM = OFF_KC + 1048576;
constexpr size_t OFF_TOPE = OFF_SELM + 131072;
constexpr size_t OFF_TOPW = OFF_TOPE + 131072;
constexpr size_t OFF_LIST = OFF_TOPW + 131072;
constexpr size_t OFF_XCH = OFF_LIST + 524288;
constexpr size_t OFF_BIAS1 = OFF_XCH + 4 * 524288;
constexpr size_t WS_END = OFF_BIAS1 + 4096;
static_assert(WS_END <= 280552448ull, "d_ws map exceeds the guaranteed workspace");
static_assert((size_t)MTOK * DFF * 2 == (size_t)MTOK * (ZQP + ZCP) * 2, "ACT overlays ZQ+ZC exactly");
constexpr int CW_TMO = 0, CW_CODE = 1;
constexpr int CW_CNT = 512;
constexpr int CW_BAR = 4096;
constexpr int CW_SEAM = 16384, SEAM_BANK = 128 * 64;
constexpr size_t CTL_ZERO_BYTES = 1u << 20;
static_assert((CW_SEAM + 4 * SEAM_BANK) * 4 <= (int)CTL_ZERO_BYTES, "CTL words inside the memset region");

constexpr int RING_OFF = 0, RING_BYTES = 131072;
constexpr int LDSCTL_OFF = RING_BYTES, MISC_OFF = LDSCTL_OFF + 320;
constexpr int LDS_BYTES = 147456;

__device__ __forceinline__ float bf2f(bf16_t v) { return __uint_as_float((unsigned)v << 16); }
__device__ __forceinline__ bf16_t f2bf(float f) { unsigned u = __float_as_uint(f); return (bf16_t)((u + 0x7fffu + ((u >> 16) & 1u)) >> 16); }
__device__ __forceinline__ unsigned pk2(float lo, float hi) { return (unsigned)f2bf(lo) | ((unsigned)f2bf(hi) << 16); }
__device__ __forceinline__ float wave_sum(float v) {
#pragma unroll
    for (int o = 32; o > 0; o >>= 1) v += __shfl_xor(v, o);
    return v;
}
__device__ __forceinline__ float wave_max(float v) {
#pragma unroll
    for (int o = 32; o > 0; o >>= 1) v = fmaxf(v, __shfl_xor(v, o));
    return v;
}
namespace pg8 {
#define PG8_LAS __attribute__((address_space(3)))
typedef short bf16x8 __attribute__((ext_vector_type(8)));
typedef float f32x4 __attribute__((ext_vector_type(4)));
typedef float f32x2 __attribute__((ext_vector_type(2)));
typedef unsigned u32x4 __attribute__((ext_vector_type(4)));
typedef unsigned u32x2 __attribute__((ext_vector_type(2)));
constexpr int BM = 256, BK = 64, HALF = 128, HTB = HALF * BK * 2  , STAGE_BYTES = 8 * HTB, NXCD = 8, WGM = 8;

__host__ __device__ __forceinline__ int lds_byte(int r, int c) { const int st = (r >> 4) * 2 + (c >> 5), rr = r & 15, cc = c & 31, ob = rr * 64 + cc * 2; return st * 1024 + (ob ^ (((ob >> 9) & 1) << 5)); }
__host__ __device__ __forceinline__ void stage_rc(int b, int& R, int& C) { const int st = b / 1024, sb = b % 1024, swz = sb ^ (((sb >> 9) & 1) << 5); R = (st >> 1) * 16 + swz / 64; C = (st & 1) * 32 + (swz % 64) / 2; }
__host__ __device__ __forceinline__ int perm32(int rho) { const int n = rho >> 4, i = rho & 15; return 8 * (i >> 2) + 4 * n + (i & 3); }

struct Unit { int pm, pn; };

struct StaticOrder {
    int nM, nN, nwg, G, c;
    __host__ __device__ void init(int nM_, int nN_, int G_, int c_) { nM = nM_; nN = nN_; nwg = nM * nN; G = G_; c = c_; }
    __host__ __device__ bool next(int i, Unit& u) const {
        const long L = (long)i * G + c; if (L >= nwg) return false;
        int wgid = (int)L; { const int q = nwg / NXCD, r = nwg % NXCD, xcd = wgid % NXCD, off = wgid / NXCD; wgid = (xcd < r ? xcd * (q + 1) : r * (q + 1) + (xcd - r) * q) + off; }
        const int nig = WGM * nN, gid = wgid / nig, fm = gid * WGM, gsz = (nM - fm) < WGM ? (nM - fm) : WGM;
        u.pm = fm + ((wgid % nig) % gsz); u.pn = (wgid % nig) / gsz; return true;
    }
};

struct APlain {
    static constexpr bool GATHER = false;
    const char* A; unsigned row_bytes;
    __device__ __forceinline__ const char* base(const Unit& u, int h) const { return A + (size_t)(u.pm * BM + h * HALF) * row_bytes; }
    __device__ __forceinline__ size_t kstep() const { return (size_t)BK * 2; }
    __device__ __forceinline__ unsigned voff(int R, int C) const { return (unsigned)R * row_bytes + (unsigned)C * 2u; }
};

struct BPlain {
    const char* Bt; size_t tstep; int relems;
    __device__ __forceinline__ const char* base(const Unit& u) const { return Bt + (size_t)u.pn * tstep; }
    __device__ __forceinline__ int row_elems() const { return relems; }
};
struct MoeLoc { int e, rt, prow0, nv; };
__device__ __forceinline__ MoeLoc moe_locate(const unsigned* cnt, int pm) {
    MoeLoc L; L.e = 0; L.rt = pm; L.prow0 = 0; L.nv = 0; int tacc = 0, racc = 0;
#pragma unroll
    for (int e = 0; e < NEXP; ++e) { const int ce = (int)cnt[e], te = (ce + 255) >> 8; if (pm >= tacc && pm < tacc + te) { L.e = e; L.rt = pm - tacc; L.prow0 = racc + L.rt * 256; L.nv = min(256, ce - L.rt * 256); } tacc += te; racc += ce; }
    return L;
}
__device__ __forceinline__ int moe_tiles(const unsigned* cnt) { int t = 0;
#pragma unroll
    for (int e = 0; e < NEXP; ++e) t += ((int)cnt[e] + 255) >> 8; return t; }
struct MoeOrder {
    int nT, nN, G, c;
    __device__ __forceinline__ bool next(int i, Unit& u) const { const int L = i * G + c; if (L >= nT * nN) return false; u.pm = L / nN; u.pn = L - u.pm * nN; return true; }
};
struct AGather {
    static constexpr bool GATHER = true;
    const char* A; unsigned row_bytes; const unsigned* cnt; const int* list;
    __device__ __forceinline__ const char* base(const Unit&, int) const { return A; }
    __device__ __forceinline__ size_t kstep() const { return (size_t)BK * 2; }
    __device__ __forceinline__ unsigned voff(int, int) const { return 0u; }
    __device__ __forceinline__ unsigned gvoff(const Unit& u, int h, int R, int C) const {
        const MoeLoc L = moe_locate(cnt, u.pm); const int idx = h * HALF + R; const int tok = (idx < L.nv) ? list[L.e * MTOK + L.rt * 256 + idx] : 0;
        return (unsigned)tok * row_bytes + (unsigned)C * 2u; }
};
struct AMoeRows {
    static constexpr bool GATHER = false;
    const char* A; unsigned row_bytes; const unsigned* cnt;
    __device__ __forceinline__ const char* base(const Unit& u, int h) const { const MoeLoc L = moe_locate(cnt, u.pm); return A + (size_t)(L.prow0 + h * HALF) * row_bytes; }
    __device__ __forceinline__ size_t kstep() const { return (size_t)BK * 2; }
    __device__ __forceinline__ unsigned voff(int R, int C) const { return (unsigned)R * row_bytes + (unsigned)C * 2u; }
};
struct BMoe {
    const char* Bt; size_t estride, tstep; int relems; const unsigned* cnt;
    __device__ __forceinline__ const char* base(const Unit& u) const { const MoeLoc L = moe_locate(cnt, u.pm); return Bt + (size_t)L.e * estride + (size_t)u.pn * tstep; }
    __device__ __forceinline__ int row_elems() const { return relems; }
};

struct ACmp {
    static constexpr bool GATHER = false;
    const char* ZQb;
    __device__ __forceinline__ const char* base(const Unit& u, int h) const { const int kv = u.pn >> 2, ks = u.pn & 3, bg = 2 * u.pm + h, b = bg >> 1, g = bg & 1;
        return ZQb + ((size_t)(b * SEQ + ks * 8) * ZQP + 512 + kv * 128 + g * 64) * 2; }
    __device__ __forceinline__ size_t kstep() const { return (size_t)ZQP * 2; }
    __device__ __forceinline__ unsigned voff(int R, int C) const { return ((unsigned)R * 16u * ZQP + (unsigned)C) * 2u; }
};
struct BCmp {
    const char* W1T;
    __device__ __forceinline__ const char* base(const Unit& u) const { return W1T + (size_t)(u.pn >> 2) * 256 * 2048 * 2 + (size_t)(u.pn & 3) * 512 * 2; }
    __device__ __forceinline__ int row_elems() const { return 2048; }
};

__device__ __forceinline__ unsigned cvt_pk_bf16(float lo, float hi) { unsigned r; asm volatile("v_cvt_pk_bf16_f32 %0, %1, %2" : "=v"(r) : "v"(lo), "v"(hi)); return r; }

struct EpiF32 {
    static constexpr bool PERM = false, AFTER_DRAIN = false;
    float* C; int ldc;
    __device__ __forceinline__ void operator()(const f32x4 (&acc)[2][2][4][2], const Unit& u, int wr, int wc, int fr, int fq) const {
        const int row0 = u.pm * BM + wr * 64 + fr, col0 = u.pn * BM + wc * 32 + 4 * fq;
#pragma unroll
        for (int ai = 0; ai < 2; ++ai)
#pragma unroll
            for (int m = 0; m < 4; ++m) { float* rowp = C + (size_t)(row0 + ai * HALF + m * 16) * ldc + col0;
#pragma unroll
                for (int bj = 0; bj < 2; ++bj)
#pragma unroll
                    for (int n = 0; n < 2; ++n) *(f32x4*)(rowp + bj * HALF + n * 16) = acc[ai][bj][m][n]; }
    }
};
struct EpiCmpPart {
    static constexpr bool PERM = false, AFTER_DRAIN = false;
    float* C;
    __device__ __forceinline__ void operator()(const f32x4 (&acc)[2][2][4][2], const Unit& u, int wr, int wc, int fr, int fq) const {
        const int row0 = u.pm * BM + wr * 64 + fr, col0 = wc * 32 + 4 * fq; float* Cb = C + (size_t)u.pn * 2048 * 256;
#pragma unroll
        for (int ai = 0; ai < 2; ++ai)
#pragma unroll
            for (int m = 0; m < 4; ++m) { float* rowp = Cb + (size_t)(row0 + ai * HALF + m * 16) * 256 + col0;
#pragma unroll
                for (int bj = 0; bj < 2; ++bj)
#pragma unroll
                    for (int n = 0; n < 2; ++n) *(f32x4*)(rowp + bj * HALF + n * 16) = acc[ai][bj][m][n]; }
    }
};
struct EpiBf16 {
    static constexpr bool PERM = true, AFTER_DRAIN = false;
    bf16_t* O; int ldc;
    __device__ __forceinline__ void operator()(const f32x4 (&acc)[2][2][4][2], const Unit& u, int wr, int wc, int fr, int fq) const {
        const int row0 = u.pm * BM + wr * 64 + fr, col0 = u.pn * BM + wc * 32 + 8 * fq;
#pragma unroll
        for (int ai = 0; ai < 2; ++ai)
#pragma unroll
            for (int m = 0; m < 4; ++m) { bf16_t* rowp = O + (size_t)(row0 + ai * HALF + m * 16) * ldc + col0;
#pragma unroll
                for (int bj = 0; bj < 2; ++bj) { const f32x4 v0 = acc[ai][bj][m][0], v1 = acc[ai][bj][m][1];
                    u32x4 w; w.x = cvt_pk_bf16(v0[0], v0[1]); w.y = cvt_pk_bf16(v0[2], v0[3]); w.z = cvt_pk_bf16(v1[0], v1[1]); w.w = cvt_pk_bf16(v1[2], v1[3]);
                    *(u32x4*)(rowp + bj * HALF) = w; } }
    }
};
struct EpiWin {
    static constexpr bool PERM = true, AFTER_DRAIN = false;
    bf16_t* ZQ; bf16_t* ZC; float* GATES;
    __device__ __forceinline__ void operator()(const f32x4 (&acc)[2][2][4][2], const Unit& u, int wr, int wc, int fr, int fq) const {
        const int row0 = u.pm * BM + wr * 64 + fr;
        if (u.pn < 11) {
            bf16_t* base; int pitch, colt;
            if (u.pn < 5) { base = ZQ; pitch = ZQP; colt = u.pn * BM; } else { base = ZC; pitch = ZCP; colt = (u.pn - 5) * BM; }
            const int col0 = colt + wc * 32 + 8 * fq;
            const float sc = (u.pn < 2) ? 0.125f * 1.4426950408889634f : 1.0f;
#pragma unroll
            for (int ai = 0; ai < 2; ++ai)
#pragma unroll
                for (int m = 0; m < 4; ++m) { bf16_t* rowp = base + (size_t)(row0 + ai * HALF + m * 16) * pitch + col0;
#pragma unroll
                    for (int bj = 0; bj < 2; ++bj) { const f32x4 v0 = acc[ai][bj][m][0] * sc, v1 = acc[ai][bj][m][1] * sc;
                        u32x4 w; w.x = cvt_pk_bf16(v0[0], v0[1]); w.y = cvt_pk_bf16(v0[2], v0[3]); w.z = cvt_pk_bf16(v1[0], v1[1]); w.w = cvt_pk_bf16(v1[2], v1[3]);
                        *(u32x4*)(rowp + bj * HALF) = w; } }
        } else if (wc == 0 && fq < 3) {
#pragma unroll
            for (int ai = 0; ai < 2; ++ai)
#pragma unroll
                for (int m = 0; m < 4; ++m) { float* gp = GATES + (size_t)(row0 + ai * HALF + m * 16) * GP + 8 * fq;
                    *(f32x4*)(gp) = acc[ai][0][m][0]; *(f32x4*)(gp + 4) = acc[ai][0][m][1]; }
        }
    }
};
__device__ __forceinline__ float silu_mul(float g, float u) { return g * __builtin_amdgcn_rcpf(1.0f + __builtin_amdgcn_exp2f(-1.4426950408889634f * g)) * u; }
struct EpiSwiglu {
    static constexpr bool PERM = true, AFTER_DRAIN = false;
    bf16_t* O; int ldc;
    __device__ __forceinline__ void operator()(const f32x4 (&acc)[2][2][4][2], const Unit& u, int wr, int wc, int fr, int fq) const {
        const int row0 = u.pm * BM + wr * 64 + fr, col0 = u.pn * HALF + wc * 32 + 8 * fq;
#pragma unroll
        for (int ai = 0; ai < 2; ++ai)
#pragma unroll
            for (int m = 0; m < 4; ++m) { bf16_t* rowp = O + (size_t)(row0 + ai * HALF + m * 16) * ldc + col0;
                const f32x4 g0 = acc[ai][0][m][0], g1 = acc[ai][0][m][1], u0 = acc[ai][1][m][0], u1 = acc[ai][1][m][1];
                u32x4 w; w.x = cvt_pk_bf16(silu_mul(g0[0], u0[0]), silu_mul(g0[1], u0[1])); w.y = cvt_pk_bf16(silu_mul(g0[2], u0[2]), silu_mul(g0[3], u0[3]));
                w.z = cvt_pk_bf16(silu_mul(g1[0], u1[0]), silu_mul(g1[1], u1[1])); w.w = cvt_pk_bf16(silu_mul(g1[2], u1[2]), silu_mul(g1[3], u1[3]));
                *(u32x4*)rowp = w; }
    }
};

struct EpiSwigluMoe {
    static constexpr bool PERM = true, AFTER_DRAIN = false;
    bf16_t* O; int ldc; const unsigned* cnt;
    __device__ __forceinline__ void operator()(const f32x4 (&acc)[2][2][4][2], const Unit& u, int wr, int wc, int fr, int fq) const {
        const MoeLoc L = moe_locate(cnt, u.pm);
        const int r0 = wr * 64 + fr, col0 = u.pn * HALF + wc * 32 + 8 * fq;
#pragma unroll
        for (int ai = 0; ai < 2; ++ai)
#pragma unroll
            for (int m = 0; m < 4; ++m) { const int r = r0 + ai * HALF + m * 16; bf16_t* rowp = O + (size_t)(L.prow0 + r) * ldc + col0;
                const f32x4 g0 = acc[ai][0][m][0], g1 = acc[ai][0][m][1], u0 = acc[ai][1][m][0], u1 = acc[ai][1][m][1];
                u32x4 w; w.x = cvt_pk_bf16(silu_mul(g0[0], u0[0]), silu_mul(g0[1], u0[1])); w.y = cvt_pk_bf16(silu_mul(g0[2], u0[2]), silu_mul(g0[3], u0[3]));
                w.z = cvt_pk_bf16(silu_mul(g1[0], u1[0]), silu_mul(g1[1], u1[1])); w.w = cvt_pk_bf16(silu_mul(g1[2], u1[2]), silu_mul(g1[3], u1[3]));
                if (r < L.nv) *(u32x4*)rowp = w; }
    }
};
struct EpiBf16Moe {
    static constexpr bool PERM = true, AFTER_DRAIN = false;
    bf16_t* O; int ldc; const unsigned* cnt;
    __device__ __forceinline__ void operator()(const f32x4 (&acc)[2][2][4][2], const Unit& u, int wr, int wc, int fr, int fq) const {
        const MoeLoc L = moe_locate(cnt, u.pm);
        const int r0 = wr * 64 + fr, col0 = u.pn * BM + wc * 32 + 8 * fq;
#pragma unroll
        for (int ai = 0; ai < 2; ++ai)
#pragma unroll
            for (int m = 0; m < 4; ++m) { const int r = r0 + ai * HALF + m * 16; bf16_t* rowp = O + (size_t)(L.prow0 + r) * ldc + col0;
                if (r < L.nv) {
#pragma unroll
                for (int bj = 0; bj < 2; ++bj) { const f32x4 v0 = acc[ai][bj][m][0], v1 = acc[ai][bj][m][1];
                    u32x4 w; w.x = cvt_pk_bf16(v0[0], v0[1]); w.y = cvt_pk_bf16(v0[2], v0[3]); w.z = cvt_pk_bf16(v1[0], v1[1]); w.w = cvt_pk_bf16(v1[2], v1[3]);
                    *(u32x4*)(rowp + bj * HALF) = w; } } }
    }
};

template <class Epi, class AP, class BP, class Sched, bool ALIGN_EPI>
__device__ __forceinline__ void gemm_phase(PG8_LAS unsigned char* lds, const AP ap, const BP bp, const int K, const Sched& S, const Epi& E, const int tid) {
    const int wid = __builtin_amdgcn_readfirstlane(tid >> 6), lane = tid & 63, wr = wid >> 2, wc = wid & 3, fr = lane & 15, fq = lane >> 4;
    const int nt = K / BK;
    unsigned voffA[2][2], voffB[2];
#pragma unroll
    for (int i = 0; i < 2; ++i) { int R, C; stage_rc(tid * 16 + i * 8192, R, C); const int Rb = Epi::PERM ? ((R & ~31) + perm32(R & 31)) : R;
        voffA[0][i] = ap.voff(R, C); voffA[1][i] = voffA[0][i]; voffB[i] = (unsigned)(Rb * bp.row_elems() + C) * 2u; }
    const size_t kstepA = ap.kstep();
    const size_t kstepB = (size_t)(BK * 2);
    const size_t hstepB = (size_t)HALF * bp.row_elems() * 2;
    const unsigned ldsw = (unsigned)wid * 1024u;
    const int aoff = lds_byte(wr * 64 + fr, fq * 8), boff = lds_byte(wc * 32 + fr, fq * 8);
#define PG8_SA(b, h) (((b) * 2 + (h)) * HTB)
#define PG8_SB(b, h) ((4 + (b) * 2 + (h)) * HTB)
#define PG8_STAGE(bufoff, gbase, voff) do { _Pragma("unroll") for (int _i = 0; _i < 2; ++_i) \
        __builtin_amdgcn_global_load_lds((const unsigned*)((const char*)(gbase) + (voff)[_i]), (PG8_LAS unsigned*)(lds + (bufoff) + ldsw + _i * 8192), 16, 0, 0); } while (0)
#define PG8_LDA(dst, b, h) do { _Pragma("unroll") for (int m = 0; m < 4; ++m) _Pragma("unroll") for (int k = 0; k < 2; ++k) dst[m][k] = *(const PG8_LAS bf16x8*)(lds + PG8_SA(b, h) + aoff + m * 2048 + k * 1024); } while (0)
#define PG8_LDB(dst, b, h) do { _Pragma("unroll") for (int n = 0; n < 2; ++n) _Pragma("unroll") for (int k = 0; k < 2; ++k) dst[n][k] = *(const PG8_LAS bf16x8*)(lds + PG8_SB(b, h) + boff + n * 2048 + k * 1024); } while (0)
#define PG8_MMA(ai, bj, At, Bt_) do { __builtin_amdgcn_s_setprio(1); _Pragma("unroll") for (int m = 0; m < 4; ++m) _Pragma("unroll") for (int n = 0; n < 2; ++n) _Pragma("unroll") for (int k = 0; k < 2; ++k) \
        acc[ai][bj][m][n] = __builtin_amdgcn_mfma_f32_16x16x32_bf16(Bt_[n][k], At[m][k], acc[ai][bj][m][n], 0, 0, 0); __builtin_amdgcn_s_setprio(0); } while (0)
#define PG8_WAIT_V(n) asm volatile("s_waitcnt vmcnt(" #n ")" ::: "memory")
#define PG8_WAIT_L(n) asm volatile("s_waitcnt lgkmcnt(" #n ")" ::: "memory")
#define PG8_BAR __builtin_amdgcn_s_barrier()
#define PG8_SCHED __builtin_amdgcn_sched_barrier(0)
    Unit cur, nxt; int ui = 0;
    if (!S.next(0, cur)) return;
    f32x4 acc[2][2][4][2];
#pragma unroll
    for (int a = 0; a < 2; ++a)
#pragma unroll
        for (int b = 0; b < 2; ++b)
#pragma unroll
            for (int m = 0; m < 4; ++m)
#pragma unroll
                for (int n = 0; n < 2; ++n) acc[a][b][m][n] = (f32x4){0.f, 0.f, 0.f, 0.f};
    bf16x8 At[4][2], B0[2][2], B1[2][2];
    const char* cA0 = ap.base(cur, 0); const char* cA1 = ap.base(cur, 1); const char* cB = bp.base(cur);
    if constexpr (AP::GATHER) {
#pragma unroll
        for (int i = 0; i < 2; ++i) { int R, C; stage_rc(tid * 16 + i * 8192, R, C); voffA[0][i] = ap.gvoff(cur, 0, R, C); voffA[1][i] = ap.gvoff(cur, 1, R, C); }
    }
    PG8_STAGE(PG8_SB(0, 0), cB, voffB); PG8_STAGE(PG8_SB(0, 1), cB + hstepB, voffB); PG8_STAGE(PG8_SA(0, 0), cA0, voffA[0]); PG8_STAGE(PG8_SA(0, 1), cA1, voffA[1]);
    if (wr == 1) PG8_BAR;
    PG8_WAIT_V(2); PG8_BAR;
    PG8_STAGE(PG8_SB(1, 0), cB + kstepB, voffB); PG8_STAGE(PG8_SA(1, 0), cA0 + kstepA, voffA[0]); PG8_STAGE(PG8_SB(1, 1), cB + hstepB + kstepB, voffB);
    PG8_WAIT_V(6); PG8_BAR;
    for (;;) {
        const bool has_next = S.next(ui + 1, nxt);
        const char* nA0 = has_next ? ap.base(nxt, 0) : cA0; const char* nA1 = has_next ? ap.base(nxt, 1) : cA1;
        const char* nB = has_next ? bp.base(nxt) : cB;
        unsigned nvo[2][2];
        if constexpr (AP::GATHER) {
#pragma unroll
            for (int i = 0; i < 2; ++i) { int R, C; stage_rc(tid * 16 + i * 8192, R, C);
                nvo[0][i] = has_next ? ap.gvoff(nxt, 0, R, C) : voffA[0][i]; nvo[1][i] = has_next ? ap.gvoff(nxt, 1, R, C) : voffA[1][i]; }
        }
        for (int t = 0; t < nt; t += 2) {
            const bool last = (t == nt - 2);
            const char* a1_1 = cA1 + (size_t)(t + 1) * kstepA;
            const char* a2_0 = last ? nA0 : cA0 + (size_t)(t + 2) * kstepA; const char* a2_1 = last ? nA1 : cA1 + (size_t)(t + 2) * kstepA;
            const char* b2 = last ? nB : cB + (size_t)(t + 2) * kstepB;
            const char* a3_0 = a2_0 + kstepA; const char* b3 = b2 + kstepB;
            PG8_LDB(B0, 0, 0); PG8_LDB(B1, 0, 1); PG8_SCHED; PG8_LDA(At, 0, 0); PG8_STAGE(PG8_SA(1, 1), a1_1, voffA[1]);
            if constexpr (AP::GATHER) { if (last) {
#pragma unroll
                for (int i = 0; i < 2; ++i) { voffA[0][i] = nvo[0][i]; voffA[1][i] = nvo[1][i]; } } }
            PG8_WAIT_V(8); PG8_WAIT_L(0); PG8_BAR; PG8_MMA(0, 0, At, B0); PG8_MMA(0, 1, At, B1); PG8_BAR; PG8_SCHED;
            PG8_LDA(At, 0, 1); PG8_STAGE(PG8_SB(0, 0), b2, voffB); PG8_STAGE(PG8_SB(0, 1), b2 + hstepB, voffB); PG8_STAGE(PG8_SA(0, 0), a2_0, voffA[0]);
            PG8_WAIT_V(8); PG8_WAIT_L(0); PG8_BAR; PG8_MMA(1, 0, At, B0); PG8_MMA(1, 1, At, B1); PG8_BAR; PG8_SCHED;
            PG8_LDB(B0, 1, 0); PG8_LDB(B1, 1, 1); PG8_SCHED; PG8_LDA(At, 1, 0); PG8_STAGE(PG8_SA(0, 1), a2_1, voffA[1]);
            PG8_WAIT_V(8); PG8_WAIT_L(0); PG8_BAR; PG8_MMA(0, 0, At, B0); PG8_MMA(0, 1, At, B1); PG8_BAR; PG8_SCHED;
            PG8_LDA(At, 1, 1); PG8_STAGE(PG8_SB(1, 0), b3, voffB); PG8_STAGE(PG8_SB(1, 1), b3 + hstepB, voffB); PG8_STAGE(PG8_SA(1, 0), a3_0, voffA[0]);
            PG8_WAIT_V(8); PG8_WAIT_L(0); PG8_BAR; PG8_MMA(1, 0, At, B0); PG8_MMA(1, 1, At, B1); PG8_BAR; PG8_SCHED;
        }
        if constexpr (ALIGN_EPI) { if (wr == 0) PG8_BAR; }
        if constexpr (!Epi::AFTER_DRAIN) { E(acc, cur, wr, wc, fr, fq); }
        if (!has_next) break;
#pragma unroll
        for (int a = 0; a < 2; ++a)
#pragma unroll
            for (int b = 0; b < 2; ++b)
#pragma unroll
                for (int m = 0; m < 4; ++m)
#pragma unroll
                    for (int n = 0; n < 2; ++n) acc[a][b][m][n] = (f32x4){0.f, 0.f, 0.f, 0.f};
        cur = nxt; cA0 = nA0; cA1 = nA1; cB = nB; ++ui;
        if constexpr (ALIGN_EPI) { if (wr == 1) PG8_BAR; }
    }
    PG8_WAIT_V(0);
    if constexpr (!ALIGN_EPI) { if (wr == 0) PG8_BAR; }
    PG8_BAR;
    if constexpr (Epi::AFTER_DRAIN) { E.fused(acc, cur, wr, wc, fr, fq, lds, wid, lane); }
#undef PG8_SA
#undef PG8_SB
#undef PG8_STAGE
#undef PG8_LDA
#undef PG8_LDB
#undef PG8_MMA
#undef PG8_WAIT_V
#undef PG8_WAIT_L
#undef PG8_BAR
#undef PG8_SCHED
}
}
#define XB_TMO      128
#define XB_XCNT(j)  (256  + 64 * (j))
#define XB_XSUB(j)  (1280 + 64 * (j))
#define XB_XGEN(j)  (2304 + 64 * (j))
#define XB_TOP      3328
#define XB_TOPGEN   3392
#define XCD_BAR_WORDS 3456
#define XB_SPIN_CAP (1u << 18)

__device__ __forceinline__ unsigned xb_ld(unsigned* p)              { return __hip_atomic_load(p, __ATOMIC_RELAXED, __HIP_MEMORY_SCOPE_AGENT); }
__device__ __forceinline__ unsigned xb_add(unsigned* p, unsigned v) { return __hip_atomic_fetch_add(p, v, __ATOMIC_RELAXED, __HIP_MEMORY_SCOPE_AGENT); }
__device__ __forceinline__ unsigned xb_xcc_id() { return (unsigned)__builtin_amdgcn_s_getreg((3 << 11) | 20) & 0xFu; }
#define XB_SPIN(cond, bar) do { unsigned _sp = 0; while (cond) { __builtin_amdgcn_s_sleep(1); \
    if ((++_sp & 255u) == 0u) { if (xb_ld(&(bar)[XB_TMO])) break; if (_sp > XB_SPIN_CAP) { atomicAdd(&(bar)[XB_TMO], 1u); break; } } } } while (0)

struct XcdBarrier {
    unsigned* bar; unsigned x;
    volatile LAS unsigned* st;
};

__device__ __forceinline__ XcdBarrier xcd_barrier_post(unsigned* bar, volatile LAS unsigned* st) {
    XcdBarrier b; b.bar = bar; b.x = xb_xcc_id(); b.st = st;
    if (threadIdx.x == 0) (void)xb_add(&bar[XB_XCNT(b.x)], 1u);
    return b;
}
__device__ __forceinline__ void xcd_barrier_complete(unsigned* bar, unsigned x, unsigned& nloc, unsigned& nx) {
    const unsigned G = gridDim.x * gridDim.y * gridDim.z;
    unsigned sum, cnt, mine, sp = 0u;
    for (;;) {
        sum = 0u; cnt = 0u; mine = 0u;
#pragma unroll
        for (unsigned j = 0; j < 16; ++j) { const unsigned c = xb_ld(&bar[XB_XCNT(j)]); sum += c; cnt += (c > 0u) ? 1u : 0u; mine = (j == x) ? c : mine; }
        if (sum == G) break;
        __builtin_amdgcn_s_sleep(1);
        if ((++sp & 255u) == 0u) { if (xb_ld(&bar[XB_TMO])) break; if (sp > XB_SPIN_CAP) { atomicAdd(&bar[XB_TMO], 1u); break; } }
    }
    nloc = mine > 0u ? mine : 1u; nx = cnt > 0u ? cnt : 1u;
}

__device__ __forceinline__ void xcd_barrier(const XcdBarrier& b) {
    asm volatile("s_waitcnt vmcnt(0)" ::: "memory");
    __syncthreads();
    if (threadIdx.x == 0) {
        unsigned* bar = b.bar;
        __builtin_amdgcn_s_waitcnt(0);
        unsigned nloc = b.st[0], nx = b.st[1];
        if (nloc == 0u) { xcd_barrier_complete(bar, b.x, nloc, nx); b.st[0] = nloc; b.st[1] = nx; }
        const unsigned old = xb_add(&bar[XB_XSUB(b.x)], 1u);
        const unsigned gen = old / nloc;
        if (old + 1u == (gen + 1u) * nloc) {
            __builtin_amdgcn_fence(__ATOMIC_RELEASE, "agent");
            asm volatile("s_waitcnt vmcnt(0)" ::: "memory");
            const unsigned og = xb_add(&bar[XB_TOP], 1u);
            const unsigned tg = og / nx;
            if (og + 1u == (tg + 1u) * nx) xb_add(&bar[XB_TOPGEN], 1u);
            else XB_SPIN(xb_ld(&bar[XB_TOPGEN]) == tg, bar);
            __builtin_amdgcn_fence(__ATOMIC_ACQUIRE, "agent");
            xb_add(&bar[XB_XGEN(b.x)], 1u);
            asm volatile("s_waitcnt vmcnt(0)" ::: "memory");
        } else {
            XB_SPIN(xb_ld(&bar[XB_XGEN(b.x)]) == gen, bar);
            __builtin_amdgcn_fence(__ATOMIC_ACQUIRE, "agent");
            asm volatile("s_waitcnt vmcnt(0)" ::: "memory");
        }
    }
    __syncthreads();
}

struct Args { const float* in[22]; float* out; unsigned char* ws; int ph_lo, ph_hi; };
struct Frame {
    LAS unsigned char* lds; unsigned char* ldsg;
    volatile LAS unsigned* MISC;
    unsigned* ctl;
    int tid, lane, wave, vcu, G;
};
#define LDS_WAIT() asm volatile("s_waitcnt lgkmcnt(0)" ::: "memory")


namespace att {
typedef short bf16x8 __attribute__((ext_vector_type(8)));
typedef short s16x4 __attribute__((ext_vector_type(4)));
typedef short v4i16_t __attribute__((ext_vector_type(4)));
typedef float f32x16 __attribute__((ext_vector_type(16)));
typedef unsigned u32x4 __attribute__((ext_vector_type(4)));
constexpr float C2 = 0.125f * 1.4426950408889634f;
constexpr float NEG = -1.0e30f;
constexpr int L_KV = 0;
constexpr int L_IMP = 32768;
constexpr int L_WSF = L_IMP + 34816;
constexpr int L_SELM = L_WSF + 2048;
constexpr int L_END = L_SELM + 512;
__device__ __forceinline__ int crow(int r, int hi) { return (r & 3) + 8 * (r >> 2) + 4 * hi; }
__device__ __forceinline__ unsigned cvtpk(float lo, float hi) { typedef float f2 __attribute__((ext_vector_type(2))); typedef __bf16 b2 __attribute__((ext_vector_type(2))); f2 v = {lo, hi}; b2 b = __builtin_convertvector(v, b2); return __builtin_bit_cast(unsigned, b); }
__device__ __forceinline__ float pmax(float v) { auto rr = __builtin_amdgcn_permlane32_swap(__float_as_uint(v), __float_as_uint(v), false, false); return fmaxf(__uint_as_float(rr[0]), __uint_as_float(rr[1])); }
__device__ __forceinline__ float psum(float v) { auto rr = __builtin_amdgcn_permlane32_swap(__float_as_uint(v), __float_as_uint(v), false, false); return __uint_as_float(rr[0]) + __uint_as_float(rr[1]); }
__device__ __forceinline__ float pother(float v, int hi) { auto rr = __builtin_amdgcn_permlane32_swap(__float_as_uint(v), __float_as_uint(v), false, false); return hi ? __uint_as_float(rr[0]) : __uint_as_float(rr[1]); }
__device__ __forceinline__ s16x4 vtr(const LAS unsigned char* p) { return __builtin_bit_cast(s16x4, __builtin_amdgcn_ds_read_tr16_b64_v4i16((LAS v4i16_t*)p)); }

#define MASK_GT(x, K, v, neg) asm volatile("v_cmp_gt_i32_e32 vcc, %2, %1\n\tv_cndmask_b32_e32 %0, %0, %3, vcc" : "+v"(x) : "v"(v), "i"(K), "v"(neg) : "vcc")
#define MASK_LE(x, K, v, neg) asm volatile("v_cmp_le_i32_e32 vcc, %2, %1\n\tv_cndmask_b32_e32 %0, %0, %3, vcc" : "+v"(x) : "v"(v), "i"(K), "v"(neg) : "vcc")
struct TileSrc { const bf16_t* k; const bf16_t* v; int pitch; };
__device__ __forceinline__ void tile_load(const TileSrc& s, int wid, int lane, u32x4& kreg, u32x4& vreg) {
    kreg = *(const u32x4*)(s.k + (size_t)lane * s.pitch + wid * 8);
    vreg = *(const u32x4*)(s.v + (size_t)(16 * (wid & 3) + (lane >> 2)) * s.pitch + (wid >> 2) * 32 + (lane & 3) * 8);
}
__device__ __forceinline__ void tile_write(LAS unsigned char* lds, int buf, int wid, int lane, const u32x4& kreg, const u32x4& vreg) {
    *(LAS u32x4*)(lds + L_KV + buf * 16384 + wid * 1024 + lane * 16) = kreg;
    *(LAS u32x4*)(lds + L_KV + buf * 16384 + 8192 + wid * 1024 + lane * 16) = vreg;
}
__device__ __forceinline__ void qkt(f32x16& p0, f32x16& p1, const LAS unsigned char* kslot, const bf16x8 (&qr)[4], int r32, int hi) {
    const LAS unsigned char* kb = kslot + hi * 1024 + r32 * 16;
    p0 = f32x16{}; p1 = f32x16{};
#pragma unroll
    for (int d0 = 0; d0 < 4; ++d0) {
        const bf16x8 b0 = *(const LAS bf16x8*)(kb + d0 * 2048), b1 = *(const LAS bf16x8*)(kb + d0 * 2048 + 512);
        p0 = __builtin_amdgcn_mfma_f32_32x32x16_bf16(b0, qr[d0], p0, 0, 0, 0);
        p1 = __builtin_amdgcn_mfma_f32_32x32x16_bf16(b1, qr[d0], p1, 0, 0, 0);
    }
}
__device__ __forceinline__ void pv(f32x16 (&o)[2], const f32x16& p0, const f32x16& p1, const LAS unsigned char* vslot, int lane, int hi) {
    const LAS unsigned char* vp = vslot + ((lane >> 4) & 1) * 32 + (lane & 3) * 8 + (4 * hi + ((lane & 15) >> 2)) * 64;
    u32x4 pw[4];
    pw[0] = (u32x4){cvtpk(p0[0], p0[1]), cvtpk(p0[2], p0[3]), cvtpk(p0[4], p0[5]), cvtpk(p0[6], p0[7])};
    pw[1] = (u32x4){cvtpk(p0[8], p0[9]), cvtpk(p0[10], p0[11]), cvtpk(p0[12], p0[13]), cvtpk(p0[14], p0[15])};
    pw[2] = (u32x4){cvtpk(p1[0], p1[1]), cvtpk(p1[2], p1[3]), cvtpk(p1[4], p1[5]), cvtpk(p1[6], p1[7])};
    pw[3] = (u32x4){cvtpk(p1[8], p1[9]), cvtpk(p1[10], p1[11]), cvtpk(p1[12], p1[13]), cvtpk(p1[14], p1[15])};
#pragma unroll
    for (int dh = 0; dh < 2; ++dh) {
        __builtin_amdgcn_sched_barrier(0);
#pragma unroll
        for (int ks = 0; ks < 4; ++ks) {
            const s16x4 lo = vtr(vp + dh * 4096 + ks * 1024), hi4 = vtr(vp + dh * 4096 + ks * 1024 + 512);
            const bf16x8 vf = (bf16x8){lo[0], lo[1], lo[2], lo[3], hi4[0], hi4[1], hi4[2], hi4[3]};
            o[dh] = __builtin_amdgcn_mfma_f32_32x32x16_bf16(__builtin_bit_cast(bf16x8, pw[ks]), vf, o[dh], 0, 0, 0);
        }
    }
}
__device__ __forceinline__ void osm(f32x16& p0, f32x16& p1, f32x16 (&o)[2], float& m, float& l, LAS float* wsf, int r32, int hi) {
    float a = fmaxf(p0[0], p1[0]);
#pragma unroll
    for (int r = 1; r < 16; ++r) a = fmaxf(a, fmaxf(p0[r], p1[r]));
    const float rm = pmax(a);
    const float mn = fmaxf(m, rm);
    const float alpha = __builtin_amdgcn_exp2f(m - mn);
    if (__ballot(mn > m) != 0ull) {
        if (hi == 0) wsf[r32] = alpha;
#pragma unroll
        for (int r = 0; r < 16; ++r) { const float f = wsf[crow(r, hi)]; o[0][r] *= f; o[1][r] *= f; }
    }
    m = mn;
    float rs = 0.f;
#pragma unroll
    for (int r = 0; r < 16; ++r) { p0[r] = __builtin_amdgcn_exp2f(p0[r] - mn); p1[r] = __builtin_amdgcn_exp2f(p1[r] - mn); rs += p0[r] + p1[r]; }
    l = l * alpha + rs;
}
__device__ __forceinline__ void fold(f32x16 (&oacc)[2], const f32x16 (&o)[2], float fac, LAS float* wsf, int r32, int hi) {
    if (hi == 0) wsf[32 + r32] = fac;
#pragma unroll
    for (int r = 0; r < 16; ++r) { const float f = wsf[32 + crow(r, hi)]; oacc[0][r] += o[0][r] * f; oacc[1][r] += o[1][r] * f; }
}

__device__ __forceinline__ void attn_unit(const Frame& F, int bg, int c, const bf16_t* ZQ, const bf16_t* KCb, const bf16_t* VCb, const float* GATES, bf16_t* OATT, unsigned* SELM) {
    LAS unsigned char* lds = F.lds;
    asm volatile("" : "+s"(ZQ), "+s"(KCb), "+s"(VCb), "+s"(GATES), "+s"(OATT), "+s"(SELM));
    int lane = F.lane; const int wid = F.wave, j = wid >> 1, th = wid & 1;
    int r32 = lane & 31, hi = lane >> 5;
    const int b = bg >> 1, g = bg & 1, head = g * HPG + j;
    int ql = 32 * th + r32;
#define REFRESH() do { asm volatile("" : "+v"(lane)); r32 = lane & 31; hi = lane >> 5; ql = 32 * th + r32; } while (0)
    const int t = 64 * c + ql; const size_t m = (size_t)b * SEQ + t;
    LAS float* wsf = (LAS float*)(lds + L_WSF) + wid * 64;
    LAS unsigned* selm = (LAS unsigned*)(lds + L_SELM);
    const bf16_t* zb = ZQ + (size_t)b * SEQ * ZQP;
    bf16x8 qr[4];
    { const bf16_t* qp = ZQ + m * ZQP + head * HD + hi * 8;
#pragma unroll
      for (int d0 = 0; d0 < 4; ++d0) qr[d0] = *(const bf16x8*)(qp + d0 * 16); }
    const float* gr = GATES + m * GP;
    const float g0 = 1.f / (1.f + __expf(-gr[head])), g1 = 1.f / (1.f + __expf(-gr[8 + head])), g2 = 1.f / (1.f + __expf(-gr[16 + head]));
    f32x16 oacc[2]; oacc[0] = f32x16{}; oacc[1] = f32x16{};
    u32x4 kreg, vreg;
    if (F.tid == 0) selm[64] = 0u;
    {
        REFRESH();
        TileSrc s0{KCb + (size_t)bg * 128 * HD, VCb + (size_t)bg * 128 * HD, HD}, s1{KCb + ((size_t)bg * 128 + 64) * HD, VCb + ((size_t)bg * 128 + 64) * HD, HD};
        tile_load(s0, wid, lane, kreg, vreg); tile_write(lds, 0, wid, lane, kreg, vreg);
        tile_load(s1, wid, lane, kreg, vreg); tile_write(lds, 1, wid, lane, kreg, vreg);
        __syncthreads();
        f32x16 a0, a1, b0, b1;
        qkt(a0, a1, lds + L_KV, qr, r32, hi); qkt(b0, b1, lds + L_KV + 16384, qr, r32, hi);
        const int nmax = (t >= 31) ? ((t - 31) >> 4) : -1;
        { const int nv = nmax - 4 * hi; const float negv = NEG;
#pragma unroll
        for (int r = 0; r < 16; ++r) { MASK_GT(a0[r], crow(r, 0), nv, negv); MASK_GT(a1[r], crow(r, 0) + 32, nv, negv); MASK_GT(b0[r], crow(r, 0) + 64, nv, negv); MASK_GT(b1[r], crow(r, 0) + 96, nv, negv); } }
        float a = NEG;
#pragma unroll
        for (int r = 0; r < 16; ++r) a = fmaxf(fmaxf(a, fmaxf(a0[r], a1[r])), fmaxf(b0[r], b1[r]));
        const float rm = pmax(a);
        float rs = 0.f;
#pragma unroll
        for (int r = 0; r < 16; ++r) { a0[r] = __builtin_amdgcn_exp2f(a0[r] - rm); a1[r] = __builtin_amdgcn_exp2f(a1[r] - rm); b0[r] = __builtin_amdgcn_exp2f(b0[r] - rm); b1[r] = __builtin_amdgcn_exp2f(b1[r] - rm);
            rs += (a0[r] + a1[r]) + (b0[r] + b1[r]); }
        const float tot = psum(rs);
        const float inv = (nmax >= 0) ? 1.0f / tot : 0.f;
#pragma unroll
        for (int r = 0; r < 16; ++r) { a0[r] *= inv; a1[r] *= inv; b0[r] *= inv; b1[r] *= inv; }
        {
            LAS float* slab = (LAS float*)(lds + L_IMP) + wid * (32 * 33) + r32 * 33;
            float prevTp = 0.f;
#define IMP_Q(q, X, q4) do { const float S_ = (X[4 * (q4)] + X[4 * (q4) + 1]) + (X[4 * (q4) + 2] + X[4 * (q4) + 3]); const float Tp_ = pother(X[4 * (q4) + 3], hi); \
                slab[2 * (q) + hi] = S_ + (hi ? Tp_ : prevTp); prevTp = Tp_; } while (0)
#pragma unroll
            for (int q4 = 0; q4 < 4; ++q4) IMP_Q(q4, a0, q4);
#pragma unroll
            for (int q4 = 0; q4 < 4; ++q4) IMP_Q(4 + q4, a1, q4);
#pragma unroll
            for (int q4 = 0; q4 < 4; ++q4) IMP_Q(8 + q4, b0, q4);
#pragma unroll
            for (int q4 = 0; q4 < 4; ++q4) IMP_Q(12 + q4, b1, q4);
#undef IMP_Q
        }
#pragma unroll
        for (int r = 0; r < 16; ++r) { a0[r] *= g0; a1[r] *= g0; b0[r] *= g0; b1[r] *= g0; }
        pv(oacc, a0, a1, lds + L_KV + 8192, lane, hi); pv(oacc, b0, b1, lds + L_KV + 16384 + 8192, lane, hi);
    }
    __syncthreads();
    {
        REFRESH();
        const LAS float* imp = (const LAS float*)(lds + L_IMP);
        const int jj = lane & 31;
#pragma unroll 1
        for (int i = 0; i < 4; ++i) {
            const int tk = 8 * wid + 2 * i + hi, tth = tk >> 5, tr = tk & 31, tt = 64 * c + tk;
            const float v = (imp[(0 + tth) * (32 * 33) + tr * 33 + jj] + imp[(2 + tth) * (32 * 33) + tr * 33 + jj]) + (imp[(4 + tth) * (32 * 33) + tr * 33 + jj] + imp[(6 + tth) * (32 * 33) + tr * 33 + jj]);
            const int cur = tt >> 6; const bool valid = (64 * jj <= tt), forced = (jj == 0) || (jj == cur) || (jj == cur - 1);
            const float score = forced ? 1e9f : (valid ? v : -1e30f);
            int rank = 0;
#pragma unroll 1
            for (int jp = 0; jp < 32; ++jp) { const float sp = __shfl(score, jp, 32); rank += (sp > score || (sp == score && jp < jj)) ? 1 : 0; }
            const unsigned long long bal = __ballot(rank < 16);
            const unsigned mk = hi ? (unsigned)(bal >> 32) : (unsigned)(bal & 0xffffffffull);
            if (jj == 0) { selm[tk] = mk; atomicOr((unsigned*)(F.ldsg + L_SELM) + 64, mk); SELM[((size_t)b * SEQ + tt) * NG + g] = mk; }
        }
    }
    __syncthreads();
    REFRESH();
    const unsigned mymask = selm[ql];
    unsigned umask = selm[64] & (c >= 31 ? 0xffffffffu : ((2u << c) - 1u));
    {
        f32x16 o[2]; o[0] = f32x16{}; o[1] = f32x16{}; float mrun = NEG, l = 0.f;
        int jt = __builtin_ctz(umask);
        { TileSrc s{zb + (size_t)(64 * jt) * ZQP + 768 + g * HD, zb + (size_t)(64 * jt) * ZQP + 896 + g * HD, ZQP}; tile_load(s, wid, lane, kreg, vreg); }
        __syncthreads();
        tile_write(lds, 0, wid, lane, kreg, vreg);
        __syncthreads();
        int buf = 0;
        while (true) {
            unsigned rest = umask & ~((2u << jt) - 1u); if (jt >= 31) rest = 0u;
            const int jn = rest ? __builtin_ctz(rest) : -1;
            if (jn >= 0) { TileSrc s{zb + (size_t)(64 * jn) * ZQP + 768 + g * HD, zb + (size_t)(64 * jn) * ZQP + 896 + g * HD, ZQP}; tile_load(s, wid, lane, kreg, vreg); }
            f32x16 p0, p1;
            qkt(p0, p1, lds + L_KV + buf * 16384, qr, r32, hi);
            const bool rowsel = (mymask >> jt) & 1u;
            if (jt == c) {
                const int qv = ql - 4 * hi; const float negv = NEG;
#pragma unroll
                for (int r = 0; r < 16; ++r) { MASK_GT(p0[r], crow(r, 0), qv, negv); MASK_GT(p1[r], crow(r, 0) + 32, qv, negv); }
            }
            if (!rowsel) {
#pragma unroll
                for (int r = 0; r < 16; ++r) { p0[r] = NEG; p1[r] = NEG; }
            }
            osm(p0, p1, o, mrun, l, wsf, r32, hi);
            pv(o, p0, p1, lds + L_KV + buf * 16384 + 8192, lane, hi);
            if (jn < 0) break;
            tile_write(lds, buf ^ 1, wid, lane, kreg, vreg);
            __syncthreads();
            buf ^= 1; jt = jn;
        }
        fold(oacc, o, g1 / psum(l), wsf, r32, hi);
    }
    {
        REFRESH();
        f32x16 o[2]; o[0] = f32x16{}; o[1] = f32x16{}; float mrun = NEG, l = 0.f;
        int jt = c >= 8 ? c - 8 : 0;
        { TileSrc s{zb + (size_t)(64 * jt) * ZQP + 1024 + g * HD, zb + (size_t)(64 * jt) * ZQP + 1152 + g * HD, ZQP}; tile_load(s, wid, lane, kreg, vreg); }
        __syncthreads();
        tile_write(lds, 0, wid, lane, kreg, vreg);
        __syncthreads();
        int buf = 0;
        while (true) {
            const int jn = (jt < c) ? jt + 1 : -1;
            if (jn >= 0) { TileSrc s{zb + (size_t)(64 * jn) * ZQP + 1024 + g * HD, zb + (size_t)(64 * jn) * ZQP + 1152 + g * HD, ZQP}; tile_load(s, wid, lane, kreg, vreg); }
            f32x16 p0, p1;
            qkt(p0, p1, lds + L_KV + buf * 16384, qr, r32, hi);
            if (jt == c) {
                const int qv = ql - 4 * hi; const float negv = NEG;
#pragma unroll
                for (int r = 0; r < 16; ++r) { MASK_GT(p0[r], crow(r, 0), qv, negv); MASK_GT(p1[r], crow(r, 0) + 32, qv, negv); }
            } else if (jt == c - 8) {
                const int qv = ql - 4 * hi; const float negv = NEG;
#pragma unroll
                for (int r = 0; r < 16; ++r) { MASK_LE(p0[r], crow(r, 0), qv, negv); MASK_LE(p1[r], crow(r, 0) + 32, qv, negv); }
            }
            osm(p0, p1, o, mrun, l, wsf, r32, hi);
            pv(o, p0, p1, lds + L_KV + buf * 16384 + 8192, lane, hi);
            if (jn < 0) break;
            tile_write(lds, buf ^ 1, wid, lane, kreg, vreg);
            __syncthreads();
            buf ^= 1; jt = jn;
        }
        fold(oacc, o, g2 / psum(l), wsf, r32, hi);
    }
    {
        REFRESH();
        LAS bf16_t* stg = (LAS bf16_t*)(lds + L_IMP) + wid * 2048;
#pragma unroll
        for (int r = 0; r < 16; ++r) { const int orow = crow(r, hi);
#pragma unroll
            for (int dh = 0; dh < 2; ++dh) stg[orow * 64 + dh * 32 + r32] = f2bf(oacc[dh][r]); }
        bf16_t* Ow = OATT + ((size_t)b * SEQ + 64 * c + 32 * th) * DM + head * HD;
#pragma unroll
        for (int i = 0; i < 4; ++i) { const int row = i * 8 + (lane >> 3), ch = lane & 7; const u32x4 v = *(const LAS u32x4*)(stg + row * 64 + ch * 8); *(u32x4*)(Ow + (size_t)row * DM + ch * 8) = v; }
    }
    __syncthreads();
#undef REFRESH
}
__device__ __forceinline__ void attn_phase(const Frame& F, const bf16_t* ZQ, const bf16_t* KCb, const bf16_t* VCb, const float* GATES, bf16_t* OATT, unsigned* SELM) {
    for (int v = F.vcu; v < 256; v += F.G) {
        const int bg = v >> 4, s = v & 15;
#pragma unroll 1
        for (int u = 0; u < 2; ++u) attn_unit(F, bg, u ? s : 31 - s, ZQ, KCb, VCb, GATES, OATT, SELM);
    }
}
}
__device__ __forceinline__ int map_row(int n, int mode) {
    if (mode == 1) return n < 1280 ? n : (n < 1304 ? 2816 + (n - 1280) : 1280 + (n - 1304));
    if (mode == 2) return (n >> 7) * 256 + (n & 127);
    if (mode == 3) return (n >> 7) * 256 + 128 + (n & 127);
    return n;
}
__device__ __forceinline__ void p0_transpose_item(const float* W, int K, int N, bf16_t* WT, int mode, LAS float* scr, int item, int lane) {
    const int nblk = (N + 31) / 32, kb = item / nblk, nb = item % nblk, k0 = 64 * kb, n0 = 32 * nb;
    const int nl = n0 + (lane & 31); const bool okl = nl < N;
#pragma unroll 8
    for (int i = 0; i < 32; ++i) { const int kk = 2 * i + (lane >> 5); scr[kk * 33 + (lane & 31)] = okl ? W[(size_t)(k0 + kk) * N + nl] : 0.f; }
    LDS_WAIT(); asm volatile("" ::: "memory");
    const int c = lane & 7;
#pragma unroll
    for (int j = 0; j < 4; ++j) { const int n = (lane >> 3) + 8 * j; const LAS float* s = scr + (8 * c) * 33 + n;
        uint4 o; o.x = pk2(s[0 * 33], s[1 * 33]); o.y = pk2(s[2 * 33], s[3 * 33]); o.z = pk2(s[4 * 33], s[5 * 33]); o.w = pk2(s[6 * 33], s[7 * 33]);
        if (n0 + n < N) *(uint4*)(WT + (size_t)map_row(n0 + n, mode) * K + k0 + 8 * c) = o; }
    LDS_WAIT(); asm volatile("" ::: "memory");
}
struct LnP { const float* X; const float* TMP; const bf16_t* TMPB; const bf16_t* PO; const int* tope; const float* topw; const unsigned* cnt; const float* g; const float* b; float* HF; bf16_t* HB; };
template <int MODE> __device__ __forceinline__ void ln_row(const LnP& a, int m, int lane, float4 (&o)[4]) {
    float4 v[4];
    if (MODE == 0) {
#pragma unroll
        for (int j = 0; j < 4; ++j) v[j] = ((const float4*)(a.X + (size_t)m * DM))[64 * j + lane];
    } else {
#pragma unroll
        for (int j = 0; j < 4; ++j) { float4 h = ((const float4*)(a.HF + (size_t)m * DM))[64 * j + lane]; v[j] = make_float4(ALPHA * h.x, ALPHA * h.y, ALPHA * h.z, ALPHA * h.w); }
        if (MODE == 1) {
#pragma unroll
            for (int j = 0; j < 4; ++j) { float4 t = ((const float4*)(a.TMP + (size_t)m * DM))[64 * j + lane]; v[j].x += t.x; v[j].y += t.y; v[j].z += t.z; v[j].w += t.w; }
        } else if (MODE == 3) {
            const bf16_t* row = a.TMPB + (size_t)m * DM;
#pragma unroll
            for (int j = 0; j < 4; ++j) { const uint2 t = ((const uint2*)row)[64 * j + lane];
                v[j].x += bf2f((bf16_t)(t.x & 0xffff)); v[j].y += bf2f((bf16_t)(t.x >> 16)); v[j].z += bf2f((bf16_t)(t.y & 0xffff)); v[j].w += bf2f((bf16_t)(t.y >> 16)); }
        } else {
            int pre[NEXP]; int acc = 0;
#pragma unroll
            for (int e = 0; e < NEXP; ++e) { pre[e] = acc; acc += (int)a.cnt[e]; }
#pragma unroll
            for (int k = 0; k < 2; ++k) {
                const int ep = a.tope[m * 2 + k], e = ep & 255, pos = ep >> 8; const float wk = a.topw[m * 2 + k];
                int p = pos;
#pragma unroll
                for (int e2 = 0; e2 < NEXP; ++e2) if (e2 == e) p += pre[e2];
                const bf16_t* row = a.PO + (size_t)p * DM;
#pragma unroll
                for (int j = 0; j < 4; ++j) { const uint2 t = ((const uint2*)row)[64 * j + lane];
                    v[j].x += wk * bf2f((bf16_t)(t.x & 0xffff)); v[j].y += wk * bf2f((bf16_t)(t.x >> 16)); v[j].z += wk * bf2f((bf16_t)(t.y & 0xffff)); v[j].w += wk * bf2f((bf16_t)(t.y >> 16)); }
            }
        }
    }
    float s = 0.f;
#pragma unroll
    for (int j = 0; j < 4; ++j) s += (v[j].x + v[j].y) + (v[j].z + v[j].w);
    const float mean = wave_sum(s) * (1.f / DM);
    float q = 0.f;
#pragma unroll
    for (int j = 0; j < 4; ++j) { v[j].x -= mean; v[j].y -= mean; v[j].z -= mean; v[j].w -= mean; q += (v[j].x * v[j].x + v[j].y * v[j].y) + (v[j].z * v[j].z + v[j].w * v[j].w); }
    const float rstd = 1.0f / sqrtf(wave_sum(q) * (1.f / DM) + LN_EPS);
#pragma unroll
    for (int j = 0; j < 4; ++j) {
        const float4 g = ((const float4*)a.g)[64 * j + lane], b = ((const float4*)a.b)[64 * j + lane];
        o[j] = make_float4(v[j].x * rstd * g.x + b.x, v[j].y * rstd * g.y + b.y, v[j].z * rstd * g.z + b.z, v[j].w * rstd * g.w + b.w);
        ((float4*)(a.HF + (size_t)m * DM))[64 * j + lane] = o[j];
        if (MODE != 2) { uint2 pk; pk.x = pk2(o[j].x, o[j].y); pk.y = pk2(o[j].z, o[j].w); ((uint2*)(a.HB + (size_t)m * DM))[64 * j + lane] = pk; }
    }
}
__device__ __forceinline__ void route_row(const float4 (&o)[4], int m, int lane, const float* Wr, unsigned* cnt, int* tope, float* topw, int* list) {
    float lg[NEXP];
#pragma unroll
    for (int e = 0; e < NEXP; ++e) lg[e] = 0.f;
#pragma unroll
    for (int j = 0; j < 4; ++j) {
        const float hv[4] = {o[j].x, o[j].y, o[j].z, o[j].w};
#pragma unroll
        for (int i = 0; i < 4; ++i) { const int d = 256 * j + 4 * lane + i; const float4 w0 = ((const float4*)(Wr + (size_t)d * NEXP))[0], w1 = ((const float4*)(Wr + (size_t)d * NEXP))[1];
            lg[0] += hv[i] * w0.x; lg[1] += hv[i] * w0.y; lg[2] += hv[i] * w0.z; lg[3] += hv[i] * w0.w; lg[4] += hv[i] * w1.x; lg[5] += hv[i] * w1.y; lg[6] += hv[i] * w1.z; lg[7] += hv[i] * w1.w; }
    }
#pragma unroll
    for (int e = 0; e < NEXP; ++e) lg[e] = wave_sum(lg[e]);
    if (lane == 0) {
        int i0 = 0; float b0 = lg[0];
#pragma unroll
        for (int e = 1; e < NEXP; ++e) if (lg[e] > b0) { b0 = lg[e]; i0 = e; }
        int i1 = -1; float b1 = -INFINITY;
#pragma unroll
        for (int e = 0; e < NEXP; ++e) if (e != i0 && lg[e] > b1) { b1 = lg[e]; i1 = e; }
        const float e1 = expf(b1 - b0), w0 = 1.f / (1.f + e1), w1 = e1 / (1.f + e1);
        const unsigned p0 = atomicAdd(&cnt[i0], 1u), p1 = atomicAdd(&cnt[i1], 1u);
        list[i0 * MTOK + p0] = m; list[i1 * MTOK + p1] = m;
        tope[m * 2] = i0 | ((int)p0 << 8); tope[m * 2 + 1] = i1 | ((int)p1 << 8);
        topw[m * 2] = w0; topw[m * 2 + 1] = w1;
    }
}

__device__ __forceinline__ void compress_reduce(const Frame& F, const float* CP, const float* bias1, const float* w2, const float* b2, bf16_t* KC) {
    const int rl = F.tid >> 6, j = F.tid & 63;
    LAS float* hid = (LAS float*)F.lds;
    for (int item = F.vcu; item < 512; item += F.G) {
        const int R = item * 8 + rl, kv = R >> 11, rr = R & 2047, i = rr & 127;
        __syncthreads();
#pragma unroll
        for (int q = 0; q < 4; ++q) { const int n = j + 64 * q; float x = bias1[kv * CMPH + n];
#pragma unroll
            for (int ks = 0; ks < 4; ++ks) x += CP[((size_t)(kv * 4 + ks) * 2048 + rr) * 256 + n];
            hid[rl * 256 + n] = 0.5f * x * (1.f + tanhf(0.7978845608028654f * (x + 0.044715f * x * x * x))); }
        __syncthreads();
        float o = b2[kv * HD + j]; const float* ww = w2 + (size_t)kv * CMPH * HD + j;
#pragma unroll 8
        for (int n = 0; n < CMPH; ++n) o += hid[rl * 256 + n] * ww[n * HD];
        KC[(size_t)R * HD + j] = f2bf(i < NCMP ? o : 0.f);
    }
}
__device__ __forceinline__ void conv_items(const Frame& F, const bf16_t* ZC, const float* cw, bf16_t* OATT) {
    for (size_t idx = (size_t)F.vcu * NTHR + F.tid; idx < (size_t)MTOK * 512; idx += (size_t)F.G * NTHR) {
        const int ch = (int)(idx & 511); const size_t m = idx >> 9; const int t = (int)(m % SEQ);
        float y = 0.f;
#pragma unroll
        for (int i = 0; i < 3; ++i) { const int dt = 2 - i; if (t - dt >= 0) { const bf16_t* r = ZC + (m - dt) * ZCP; y += bf2f(r[1024 + ch]) * bf2f(r[ch]) * cw[i * 512 + ch]; } }
        OATT[m * DM + 512 + ch] = f2bf(bf2f(ZC[m * ZCP + 512 + ch]) * y);
    }
}


constexpr int NPHASE = 19;
__global__ void __launch_bounds__(NTHR, 2) mega_fwd(Args args) {
    extern __shared__ __attribute__((aligned(16))) unsigned char lds[];
    Frame F;
    F.lds = (LAS unsigned char*)lds; F.ldsg = lds;
    F.MISC = (volatile LAS unsigned*)(F.lds + MISC_OFF);
    F.tid = threadIdx.x; F.lane = F.tid & 63; F.wave = __builtin_amdgcn_readfirstlane(F.tid >> 6);
    F.G = gridDim.x; { const int bx = blockIdx.x; F.vcu = (F.G % 8 == 0) ? (bx % 8) * (F.G / 8) + bx / 8 : bx; }
    for (int u = F.tid; u < (LDS_BYTES - LDSCTL_OFF) / 4; u += NTHR) ((LAS unsigned*)(F.lds + LDSCTL_OFF))[u] = 0u;
    __syncthreads();
    const int lo = args.ph_lo, hi = args.ph_hi;
    F.ctl = nullptr;
    const bool one_launch = (hi - lo) > 1;
#define KA() ({ const __attribute__((address_space(4))) Args* p_ = (const __attribute__((address_space(4))) Args*)__builtin_amdgcn_kernarg_segment_ptr(); asm volatile("" : "+s"(p_)); p_; })
#define WS(off) (KA()->ws + (off))
#define INP(i) (KA()->in[i])
    XcdBarrier bar; bar.bar = nullptr; bar.x = 0; bar.st = nullptr;
    if (one_launch) bar = xcd_barrier_post((unsigned*)WS(OFF_CTL) + CW_BAR, F.MISC + 8);
#define IN(k) ({ int lo_ = lo, hi_ = hi; asm volatile("" : "+s"(lo_), "+s"(hi_)); (lo_ <= (k) && (k) < hi_); })
#define FRESH() do { asm volatile("" : "+v"(F.tid)); F.lane = F.tid & 63; } while (0)
#define SEAM(k) do { if (IN(k) && IN((k) + 1)) { XcdBarrier b2_; b2_.bar = (unsigned*)WS(OFF_CTL) + CW_BAR; b2_.x = bar.x; b2_.st = bar.st; xcd_barrier(b2_); } } while (0)
    const int gw = F.vcu * NWAVES + F.wave, NGW = F.G * NWAVES;

    if (IN(0)) { FRESH();
        LAS float* scr = (LAS float*)(F.lds + RING_OFF + F.wave * 16384);
        bf16_t* WIN_T = (bf16_t*)WS(OFF_WIN_T);
        for (int l = 0; l < DEPTH; ++l) { uint4* p = (uint4*)(WIN_T + (size_t)l * DINP * DM + (size_t)DIN * DM); const int n16 = (DINP - DIN) * DM * 2 / 16;
            for (int i = F.vcu * NTHR + F.tid; i < n16; i += F.G * NTHR) p[i] = make_uint4(0, 0, 0, 0); }
        int it0 = gw;
#define P0_TASK(Wp, K_, N_, WTp, mode_) do { const int nit_ = ((K_) / 64) * (((N_) + 31) / 32); \
            for (; it0 < nit_; it0 += NGW) p0_transpose_item((Wp), (K_), (N_), (WTp), (mode_), scr, it0, F.lane); it0 -= nit_; } while (0)
        for (int l = 0; l < DEPTH; ++l) {
            P0_TASK(INP(3) + (size_t)l * DM * DIN, DM, DIN, (bf16_t*)WS(OFF_WIN_T) + (size_t)l * DINP * DM, 1);
            P0_TASK(INP(10) + (size_t)l * DM * DM, DM, DM, (bf16_t*)WS(OFF_WO_T) + (size_t)l * DM * DM, 0);
        }
        for (int lk = 0; lk < 4; ++lk) P0_TASK(INP(5) + (size_t)lk * 2048 * CMPH, 2048, CMPH, (bf16_t*)WS(OFF_CW1_T) + (size_t)lk * CMPH * 2048, 0);
        P0_TASK(INP(15), DM, DFF, (bf16_t*)WS(OFF_FGU_T), 2);
        P0_TASK(INP(16), DM, DFF, (bf16_t*)WS(OFF_FGU_T), 3);
        P0_TASK(INP(17), DFF, DM, (bf16_t*)WS(OFF_FD_T), 0);
        for (int e = 0; e < NEXP; ++e) {
            P0_TASK(INP(19) + (size_t)e * DM * DFFE, DM, DFFE, (bf16_t*)WS(OFF_MGU_T) + (size_t)e * 2 * DFFE * DM, 2);
            P0_TASK(INP(20) + (size_t)e * DM * DFFE, DM, DFFE, (bf16_t*)WS(OFF_MGU_T) + (size_t)e * 2 * DFFE * DM, 3);
            P0_TASK(INP(21) + (size_t)e * DFFE * DM, DFFE, DM, (bf16_t*)WS(OFF_MD_T) + (size_t)e * DM * DFFE, 0);
        }
#undef P0_TASK
        if (F.vcu < 2) {
            const int idx = F.vcu * NTHR + F.tid, lk = idx >> 8, n = idx & 255;
            const float* pos = INP(4) + (size_t)lk * 2048; const float* w1 = INP(5) + (size_t)lk * 2048 * CMPH + n;
            float acc = INP(6)[lk * CMPH + n];
            for (int kk = 0; kk < 2048; ++kk) acc += pos[kk] * w1[(size_t)kk * CMPH];
            ((float*)WS(OFF_BIAS1))[idx] = acc;
        }
        LnP a{}; a.X = INP(0); a.g = INP(1); a.b = INP(2); a.HF = KA()->out; a.HB = (bf16_t*)WS(OFF_HB);
        for (int m = gw; m < MTOK; m += NGW) { float4 o[4]; ln_row<0>(a, m, F.lane, o); }
    }
    SEAM(0);
    for (int l = 0; l < DEPTH; ++l) {
        const int pb = 1 + 9 * l;
        if (IN(pb + 0)) { FRESH();
            pg8::APlain ap{(const char*)WS(OFF_HB), (unsigned)DM * 2u}; pg8::StaticOrder S; S.init(MTOK / 256, DINP / 256, F.G, (int)blockIdx.x);
            pg8::EpiWin E{(bf16_t*)WS(OFF_ZQ), (bf16_t*)WS(OFF_ZC), (float*)WS(OFF_GATES)};
            pg8::BPlain bp{(const char*)((const bf16_t*)WS(OFF_WIN_T) + (size_t)l * DINP * DM), (size_t)256 * DM * 2, DM};
            pg8::gemm_phase<pg8::EpiWin, pg8::APlain, pg8::BPlain, pg8::StaticOrder, true>(F.lds + RING_OFF, ap, bp, DM, S, E, F.tid);
        }
        SEAM(pb + 0);
        if (IN(pb + 1)) { FRESH();
            pg8::ACmp ap{(const char*)WS(OFF_ZQ)}; pg8::BCmp bp{(const char*)((const bf16_t*)WS(OFF_CW1_T) + (size_t)l * 2 * CMPH * 2048)};
            pg8::StaticOrder S; S.init(8, 8, F.G, (int)blockIdx.x);
            pg8::EpiCmpPart E{(float*)WS(OFF_HB)};
            pg8::gemm_phase<pg8::EpiCmpPart, pg8::ACmp, pg8::BCmp, pg8::StaticOrder, true>(F.lds + RING_OFF, ap, bp, 512, S, E, F.tid);
            conv_items(F, (const bf16_t*)WS(OFF_ZC), INP(9) + (size_t)l * 3 * 512, (bf16_t*)WS(OFF_OATT));
        }
        SEAM(pb + 1);
        if (IN(pb + 2)) { FRESH();
            compress_reduce(F, (const float*)WS(OFF_HB), (const float*)WS(OFF_BIAS1) + (size_t)l * 2 * CMPH, INP(7) + (size_t)l * 2 * CMPH * HD, INP(8) + (size_t)l * 2 * HD, (bf16_t*)WS(OFF_KC));
        }
        SEAM(pb + 2);
        if (IN(pb + 3)) { FRESH(); __syncthreads(); att::attn_phase(F, (const bf16_t*)WS(OFF_ZQ), (const bf16_t*)WS(OFF_KC), (const bf16_t*)WS(OFF_KC) + (size_t)BATCH * NG * 128 * HD, (const float*)WS(OFF_GATES), (bf16_t*)WS(OFF_OATT), (unsigned*)WS(OFF_SELM)); }
        SEAM(pb + 3);
        if (IN(pb + 4)) { FRESH();
            __syncthreads();
            pg8::APlain ap{(const char*)WS(OFF_OATT), (unsigned)DM * 2u}; pg8::StaticOrder S; S.init(MTOK / 256, DM / 256, F.G, (int)blockIdx.x);
            pg8::EpiF32 E{(float*)WS(OFF_ZQ), DM};
            pg8::BPlain bp{(const char*)((const bf16_t*)WS(OFF_WO_T) + (size_t)l * DM * DM), (size_t)256 * DM * 2, DM};
            pg8::gemm_phase<pg8::EpiF32, pg8::APlain, pg8::BPlain, pg8::StaticOrder, true>(F.lds + RING_OFF, ap, bp, DM, S, E, F.tid);
        }
        SEAM(pb + 4);
        if (IN(pb + 5)) { FRESH();
            LnP a{}; a.TMP = (const float*)WS(OFF_ZQ); a.g = INP(11) + l * DM; a.b = INP(12) + l * DM; a.HF = KA()->out; a.HB = (bf16_t*)WS(OFF_HB);
            const float* Wr = INP(18); unsigned* cnt = (unsigned*)WS(OFF_CTL) + CW_CNT; int* TOPE = (int*)WS(OFF_TOPE); float* TOPW = (float*)WS(OFF_TOPW); int* LIST = (int*)WS(OFF_LIST);
            for (int m = gw; m < MTOK; m += NGW) { float4 o[4]; ln_row<1>(a, m, F.lane, o); if (l & 1) route_row(o, m, F.lane, Wr, cnt, TOPE, TOPW, LIST); }
        }
        SEAM(pb + 5);
        if ((l & 1) == 0) {
            if (IN(pb + 6)) { FRESH();
                pg8::APlain ap{(const char*)WS(OFF_HB), (unsigned)DM * 2u}; pg8::StaticOrder S; S.init(MTOK / 256, 2 * DFF / 256, F.G, (int)blockIdx.x);
                pg8::EpiSwiglu E{(bf16_t*)WS(OFF_ZQ), DFF};
                pg8::BPlain bp{(const char*)WS(OFF_FGU_T), (size_t)256 * DM * 2, DM};
                pg8::gemm_phase<pg8::EpiSwiglu, pg8::APlain, pg8::BPlain, pg8::StaticOrder, true>(F.lds + RING_OFF, ap, bp, DM, S, E, F.tid);
            }
            SEAM(pb + 6);
            if (IN(pb + 7)) { FRESH();
                pg8::APlain ap{(const char*)WS(OFF_ZQ), (unsigned)DFF * 2u}; pg8::StaticOrder S; S.init(MTOK / 256, DM / 256, F.G, (int)blockIdx.x);
                pg8::EpiBf16 E{(bf16_t*)WS(OFF_OATT), DM};
                pg8::BPlain bp{(const char*)WS(OFF_FD_T), (size_t)256 * DFF * 2, DFF};
                pg8::gemm_phase<pg8::EpiBf16, pg8::APlain, pg8::BPlain, pg8::StaticOrder, true>(F.lds + RING_OFF, ap, bp, DFF, S, E, F.tid);
            }
            SEAM(pb + 7);
            if (IN(pb + 8)) { FRESH();
                LnP a{}; a.TMPB = (const bf16_t*)WS(OFF_OATT); a.g = INP(13) + l * DM; a.b = INP(14) + l * DM; a.HF = KA()->out; a.HB = (bf16_t*)WS(OFF_HB);
                for (int m = gw; m < MTOK; m += NGW) { float4 o[4]; ln_row<3>(a, m, F.lane, o); }
            }
            SEAM(pb + 8);
        } else {
            if (IN(pb + 6)) { FRESH(); __syncthreads(); { const unsigned* cnt = (const unsigned*)WS(OFF_CTL) + CW_CNT;
                pg8::AGather ap{(const char*)WS(OFF_HB), (unsigned)DM * 2u, cnt, (const int*)WS(OFF_LIST)};
                pg8::BMoe bp{(const char*)WS(OFF_MGU_T), (size_t)2 * DFFE * DM * 2, (size_t)256 * DM * 2, DM, cnt};
                pg8::MoeOrder S{pg8::moe_tiles(cnt), 2 * DFFE / 256, F.G, (int)blockIdx.x};
                pg8::EpiSwigluMoe E{(bf16_t*)WS(OFF_ZQ), DFFE, cnt};
                pg8::gemm_phase<pg8::EpiSwigluMoe, pg8::AGather, pg8::BMoe, pg8::MoeOrder, true>(F.lds + RING_OFF, ap, bp, DM, S, E, F.tid); } }
            SEAM(pb + 6);
            if (IN(pb + 7)) { FRESH(); __syncthreads(); { const unsigned* cnt = (const unsigned*)WS(OFF_CTL) + CW_CNT;
                pg8::AMoeRows ap{(const char*)WS(OFF_ZQ), (unsigned)DFFE * 2u, cnt};
                pg8::BMoe bp{(const char*)WS(OFF_MD_T), (size_t)DM * DFFE * 2, (size_t)256 * DFFE * 2, DFFE, cnt};
                pg8::MoeOrder S{pg8::moe_tiles(cnt), DM / 256, F.G, (int)blockIdx.x};
                pg8::EpiBf16Moe E{(bf16_t*)WS(OFF_HB), DM, cnt};
                pg8::gemm_phase<pg8::EpiBf16Moe, pg8::AMoeRows, pg8::BMoe, pg8::MoeOrder, true>(F.lds + RING_OFF, ap, bp, DFFE, S, E, F.tid); } }
            SEAM(pb + 7);
            if (IN(pb + 8)) { FRESH();
                LnP a{}; a.PO = (const bf16_t*)WS(OFF_HB); a.tope = (const int*)WS(OFF_TOPE); a.topw = (const float*)WS(OFF_TOPW); a.cnt = (const unsigned*)WS(OFF_CTL) + CW_CNT; a.g = INP(13) + l * DM; a.b = INP(14) + l * DM; a.HF = KA()->out; a.HB = (bf16_t*)WS(OFF_HB);
                for (int m = gw; m < MTOK; m += NGW) { float4 o[4]; ln_row<2>(a, m, F.lane, o); }
            }
            SEAM(pb + 8);
        }
    }
#undef IN
#undef FRESH
#undef SEAM
#undef KA
#undef WS
#undef INP
}

#ifndef MK_N_LAUNCHES
#define MK_N_LAUNCHES 1
#endif
extern "C" void kernel_launch(void* const* d_in, const int* in_sizes, int n_in, void* d_out, int out_size, void* d_ws, size_t ws_size, hipStream_t stream) {
    (void)in_sizes; (void)out_size; (void)ws_size;
    static int grid = 0;
    if (grid == 0) {
        int dev = 0, cus = 0, per_cu = 0;
        if (n_in != 22 || hipGetDevice(&dev) != hipSuccess || hipDeviceGetAttribute(&cus, hipDeviceAttributeMultiprocessorCount, dev) != hipSuccess) { grid = -1; return; }
        if (hipFuncSetAttribute((const void*)mega_fwd, hipFuncAttributeMaxDynamicSharedMemorySize, LDS_BYTES) != hipSuccess) { grid = -1; return; }
        if (hipOccupancyMaxActiveBlocksPerMultiprocessor(&per_cu, (const void*)mega_fwd, NTHR, LDS_BYTES) != hipSuccess || per_cu < 1) { grid = -1; return; }
        (void)hipGetLastError();
        grid = cus;
    }
    if (grid < 0) return;
    (void)hipMemsetAsync((char*)d_ws + OFF_CTL, 0, CTL_ZERO_BYTES, stream);
    Args a{};
    for (int i = 0; i < 22; ++i) a.in[i] = (const float*)d_in[i];
    a.out = (float*)d_out; a.ws = (unsigned char*)d_ws;
    if (MK_N_LAUNCHES == 1) {
        a.ph_lo = 0; a.ph_hi = NPHASE;
        void* kargs[] = {&a};
        (void)hipLaunchCooperativeKernel((const void*)mega_fwd, dim3(grid), dim3(NTHR), kargs, LDS_BYTES, stream);
    } else {
        for (int p = 0; p < NPHASE; ++p) { a.ph_lo = p; a.ph_hi = p + 1; hipLaunchKernelGGL(mega_fwd, dim3(grid), dim3(NTHR), LDS_BYTES, stream, a); }
    }
}
```
